# Optimizing an MI355X kernel written in HIP

```python
import jax, jax.numpy as jnp
from jax import lax
import numpy as np

D_MODEL = 2048
BATCH = 1
SEQ = 16384
DEPTH = 1
DEC_BATCH = 32
DEC_SEQ = 4
PAST_LEN = 16384
PAGE_SIZE = 128

POOL_WIDTH = D_MODEL // 2
POOL_WINDOWS = (2, 4, 8, 16)
POOL_GROUP = POOL_WIDTH // len(POOL_WINDOWS)
POOL_STATE = max(POOL_WINDOWS) - 1
HEAD_DIM = 128
N_HEADS = (D_MODEL - POOL_WIDTH) // HEAD_DIM
ATTN_WIDTH = N_HEADS * HEAD_DIM
DILATIONS = ((128, 1), (512, 4), (2048, 16))
MAX_WINDOW = 2048
Q_BLOCK = 128
ROPE_THETA = 10000.0
N_MEM = 256
MEM_HEADS = 4
MEM_HEAD_DIM = 128
MEM_WIDTH = MEM_HEADS * MEM_HEAD_DIM
D_FF = 5632
CONV_WIDTH = 3
EPS = 1e-6
NEG_INF = -1e30
IN_WIDTH = POOL_WIDTH + 3 * ATTN_WIDTH

kernel_name = "hybrid_pool_dilated_attn_decoder_step"


def _rms_norm(x, gain):
    xf = x.astype(jnp.float32)
    y = xf * lax.rsqrt(jnp.mean(xf * xf, axis=-1, keepdims=True) + EPS)
    return (y * gain.astype(jnp.float32)).astype(x.dtype)


def _rope(x, pos):
    half = HEAD_DIM // 2
    inv = 1.0 / (ROPE_THETA ** (jnp.arange(half, dtype=jnp.float32) * (2.0 / HEAD_DIM)))
    ang = pos.astype(jnp.float32)[:, None] * inv[None, :]
    cos = jnp.cos(ang)[None, :, None, :]
    sin = jnp.sin(ang)[None, :, None, :]
    xf = x.astype(jnp.float32)
    x1, x2 = xf[..., :half], xf[..., half:]
    return jnp.concatenate([x1 * cos - x2 * sin, x1 * sin + x2 * cos], axis=-1).astype(x.dtype)


def _multi_scale_pool(u_ext, pos, w_pool, pool_scale):
    t = pos.shape[0]
    prefix = u_ext.shape[1] - t
    uf = u_ext.astype(jnp.float32)
    cs = jnp.concatenate([jnp.zeros_like(uf[:, :1]), jnp.cumsum(uf, axis=1)], axis=1)
    end = cs[:, prefix + 1:]
    u_t = uf[:, prefix:]
    outs = []
    for g, w in enumerate(POOL_WINDOWS):
        sl = slice(g * POOL_GROUP, (g + 1) * POOL_GROUP)
        start = cs[:, prefix + 1 - w: prefix + 1 - w + t, sl]
        cnt = jnp.minimum(pos + 1, w).astype(jnp.float32)[None, :, None]
        diff = (end[..., sl] - start) / cnt - u_t[..., sl]
        outs.append(jnp.einsum("btc,cd->btd", diff, w_pool[g].astype(jnp.float32)))
    y = jnp.concatenate(outs, axis=-1) * pool_scale.astype(jnp.float32)
    return y.astype(u_ext.dtype)


def _dilated_block(q, qpos, qidx, k_ext, v_ext):
    scale = HEAD_DIM ** -0.5
    outs, lses = [], []
    for window, dil in DILATIONS:
        dist = dil * jnp.arange(window // dil + 1)
        valid = (qpos[:, None] - dist[None, :]) >= 0
        idx = jnp.maximum(qidx[:, None] - dist[None, :], 0)
        kg = jnp.take(k_ext, idx, axis=1)
        vg = jnp.take(v_ext, idx, axis=1)
        s = jnp.einsum("bthd,btkhd->bthk", q, kg, preferred_element_type=jnp.float32) * scale
        s = jnp.where(valid[None, :, None, :], s, NEG_INF)
        m = jnp.max(s, axis=-1, keepdims=True)
        e = jnp.exp(s - m)
        den = jnp.sum(e, axis=-1)
        o = jnp.einsum("bthk,btkhd->bthd", e, vg.astype(jnp.float32)) / den[..., None]
        outs.append(o)
        lses.append(m[..., 0] + jnp.log(den))
    w = jax.nn.softmax(jnp.stack(lses, axis=0), axis=0)
    out = jnp.sum(w[..., None] * jnp.stack(outs, axis=0), axis=0)
    return out.astype(q.dtype)


def _dilated_attention(q, pos, k_ext, v_ext):
    t = q.shape[1]
    prefix = k_ext.shape[1] - t
    qidx = prefix + jnp.arange(t)
    if t % Q_BLOCK == 0 and t > Q_BLOCK:
        def blk(b):
            s0 = b * Q_BLOCK
            return _dilated_block(lax.dynamic_slice_in_dim(q, s0, Q_BLOCK, 1),
                                  lax.dynamic_slice_in_dim(pos, s0, Q_BLOCK, 0),
                                  lax.dynamic_slice_in_dim(qidx, s0, Q_BLOCK, 0),
                                  k_ext, v_ext)
        o = lax.map(blk, jnp.arange(t // Q_BLOCK))
        return jnp.moveaxis(o, 0, 1).reshape(q.shape)
    return _dilated_block(q, pos, qidx, k_ext, v_ext)


def _memory_kv(mem, norm_src, w_k, w_v, k_norm):
    b, n = mem.shape[:2]
    m = _rms_norm(mem, norm_src)
    k = _rms_norm((m @ w_k).reshape(b, n, MEM_HEADS, MEM_HEAD_DIM), k_norm)
    v = (m @ w_v).reshape(b, n, MEM_HEADS, MEM_HEAD_DIM)
    return k, v


def _memory_attention(h, mem_k, mem_v, w_q, q_norm, w_o):
    b, t = h.shape[:2]
    q = _rms_norm((h @ w_q).reshape(b, t, MEM_HEADS, MEM_HEAD_DIM), q_norm)
    s = jnp.einsum("bthd,bmhd->bhtm", q, mem_k, preferred_element_type=jnp.float32) * (MEM_HEAD_DIM ** -0.5)
    p = jax.nn.softmax(s, axis=-1)
    o = jnp.einsum("bhtm,bmhd->bthd", p, mem_v.astype(jnp.float32))
    return o.reshape(b, t, MEM_WIDTH).astype(h.dtype) @ w_o


def _conv_ffn(h, conv_prev, w_gate, w_up, conv_w, conv_b, w_down):
    t = h.shape[1]
    g = h @ w_gate
    up = h @ w_up
    g_ext = jnp.concatenate([conv_prev, g], axis=1)
    c = conv_b + sum(g_ext[:, j:j + t] * conv_w[j] for j in range(CONV_WIDTH))
    y = (jax.nn.silu(c) * up) @ w_down
    return y, g_ext[:, -(CONV_WIDTH - 1):]


def _layer(x, pos, pool_prev, k_prev, v_prev, mem_k, mem_v, conv_prev, p):
    b, t = x.shape[:2]
    h = _rms_norm(x, p["norm_mix"])
    proj = h @ p["w_in"]
    u = proj[..., :POOL_WIDTH]
    q = proj[..., POOL_WIDTH:POOL_WIDTH + ATTN_WIDTH].reshape(b, t, N_HEADS, HEAD_DIM)
    k = proj[..., POOL_WIDTH + ATTN_WIDTH:POOL_WIDTH + 2 * ATTN_WIDTH].reshape(b, t, N_HEADS, HEAD_DIM)
    v = proj[..., POOL_WIDTH + 2 * ATTN_WIDTH:].reshape(b, t, N_HEADS, HEAD_DIM)
    q = _rope(_rms_norm(q, p["q_norm"]), pos)
    k = _rope(_rms_norm(k, p["k_norm"]), pos)
    u_ext = jnp.concatenate([pool_prev, u], axis=1)
    pool_out = _multi_scale_pool(u_ext, pos, p["w_pool"], p["pool_scale"])
    attn_out = _dilated_attention(q, pos, jnp.concatenate([k_prev, k], axis=1),
                                  jnp.concatenate([v_prev, v], axis=1))
    mixed = jnp.concatenate([pool_out, attn_out.reshape(b, t, ATTN_WIDTH)], axis=-1)
    x = x + mixed @ p["w_out"]
    x = x + _memory_attention(_rms_norm(x, p["norm_mem"]), mem_k, mem_v,
                              p["w_mem_q"], p["mem_q_norm"], p["w_mem_o"])
    f, conv_state = _conv_ffn(_rms_norm(x, p["norm_ffn"]), conv_prev, p["w_gate"], p["w_up"],
                              p["conv_w"], p["conv_b"], p["w_down"])
    x = x + f
    return x, u_ext[:, -POOL_STATE:], k, v, conv_state


def setup_inputs(seed: int = 0) -> dict:
    key = jax.random.key(seed)
    ks = iter(jax.random.split(key, 40))
    f32 = jnp.float32

    def nrm(shape, scale):
        return jax.random.normal(next(ks), shape, f32) * scale

    def gain(shape):
        return 1.0 + nrm(shape, 0.02)

    win_buf = min(MAX_WINDOW, PAST_LEN)
    return {
        "x_prompt": nrm((BATCH, SEQ, D_MODEL), 1.0),
        "x_sample": nrm((DEC_BATCH, DEC_SEQ, D_MODEL), 1.0),
        "state_pool": nrm((DEPTH, DEC_BATCH, POOL_STATE, POOL_WIDTH), 1.0),
        "cache_win_k": nrm((DEPTH, DEC_BATCH, win_buf, N_HEADS, HEAD_DIM), 1.0),
        "cache_win_v": nrm((DEPTH, DEC_BATCH, win_buf, N_HEADS, HEAD_DIM), 1.0),
        "cache_mem_k": nrm((DEPTH, DEC_BATCH, N_MEM, MEM_HEADS, MEM_HEAD_DIM), 1.0),
        "cache_mem_v": nrm((DEPTH, DEC_BATCH, N_MEM, MEM_HEADS, MEM_HEAD_DIM), 1.0),
        "state_conv": nrm((DEPTH, DEC_BATCH, CONV_WIDTH - 1, D_FF), 1.0),
        "mem_prompt": nrm((BATCH, N_MEM, D_MODEL), 1.0),
        "norm_mix": gain((DEPTH, D_MODEL)),
        "w_in": nrm((DEPTH, D_MODEL, IN_WIDTH), D_MODEL ** -0.5),
        "q_norm": gain((DEPTH, HEAD_DIM)),
        "k_norm": gain((DEPTH, HEAD_DIM)),
        "w_pool": nrm((DEPTH, len(POOL_WINDOWS), POOL_GROUP, POOL_GROUP), POOL_GROUP ** -0.5),
        "pool_scale": gain((DEPTH, POOL_WIDTH)),
        "w_out": nrm((DEPTH, D_MODEL, D_MODEL), D_MODEL ** -0.5),
        "norm_mem": gain((DEPTH, D_MODEL)),
        "norm_mem_src": gain((DEPTH, D_MODEL)),
        "w_mem_q": nrm((DEPTH, D_MODEL, MEM_WIDTH), D_MODEL ** -0.5),
        "w_mem_k": nrm((DEPTH, D_MODEL, MEM_WIDTH), D_MODEL ** -0.5),
        "w_mem_v": nrm((DEPTH, D_MODEL, MEM_WIDTH), D_MODEL ** -0.5),
        "mem_q_norm": gain((DEPTH, MEM_HEAD_DIM)),
        "mem_k_norm": gain((DEPTH, MEM_HEAD_DIM)),
        "w_mem_o": nrm((DEPTH, MEM_WIDTH, D_MODEL), MEM_WIDTH ** -0.5),
        "norm_ffn": gain((DEPTH, D_MODEL)),
        "w_gate": nrm((DEPTH, D_MODEL, D_FF), D_MODEL ** -0.5),
        "w_up": nrm((DEPTH, D_MODEL, D_FF), D_MODEL ** -0.5),
        "conv_w": nrm((DEPTH, CONV_WIDTH, D_FF), CONV_WIDTH ** -0.5),
        "conv_b": nrm((DEPTH, D_FF), 0.02),
        "w_down": nrm((DEPTH, D_FF, D_MODEL), D_FF ** -0.5),
    }


def reference(x_prompt, x_sample, state_pool, cache_win_k, cache_win_v, cache_mem_k, cache_mem_v,
              state_conv, mem_prompt, norm_mix, w_in, q_norm, k_norm, w_pool, pool_scale, w_out,
              norm_mem, norm_mem_src, w_mem_q, w_mem_k, w_mem_v, mem_q_norm, mem_k_norm, w_mem_o,
              norm_ffn, w_gate, w_up, conv_w, conv_b, w_down):
    bp, tp = x_prompt.shape[:2]
    ts = x_sample.shape[1]
    pos_p = jnp.arange(tp)
    pos_s = PAST_LEN + jnp.arange(ts)
    keep_p = min(MAX_WINDOW, tp)
    dt = x_prompt.dtype
    xp, xs = x_prompt, x_sample
    p_pool, p_k, p_v, p_mk, p_mv, p_conv = [], [], [], [], [], []
    s_pool, s_k, s_v, s_conv = [], [], [], []
    for l in range(DEPTH):
        prm = {
            "norm_mix": norm_mix[l], "w_in": w_in[l], "q_norm": q_norm[l], "k_norm": k_norm[l],
            "w_pool": w_pool[l], "pool_scale": pool_scale[l], "w_out": w_out[l],
            "norm_mem": norm_mem[l], "w_mem_q": w_mem_q[l], "mem_q_norm": mem_q_norm[l],
            "w_mem_o": w_mem_o[l], "norm_ffn": norm_ffn[l], "w_gate": w_gate[l], "w_up": w_up[l],
            "conv_w": conv_w[l], "conv_b": conv_b[l], "w_down": w_down[l],
        }
        mk, mv = _memory_kv(mem_prompt, norm_mem_src[l], w_mem_k[l], w_mem_v[l], mem_k_norm[l])
        xp, pool_st, kp, vp, conv_st = _layer(
            xp, pos_p,
            jnp.zeros((bp, POOL_STATE, POOL_WIDTH), dt),
            jnp.zeros((bp, MAX_WINDOW, N_HEADS, HEAD_DIM), dt),
            jnp.zeros((bp, MAX_WINDOW, N_HEADS, HEAD_DIM), dt),
            mk, mv,
            jnp.zeros((bp, CONV_WIDTH - 1, D_FF), dt), prm)
        p_pool.append(pool_st); p_k.append(kp[:, -keep_p:]); p_v.append(vp[:, -keep_p:])
        p_mk.append(mk); p_mv.append(mv); p_conv.append(conv_st)
        xs, pool_st_s, ks_new, vs_new, conv_st_s = _layer(
            xs, pos_s, state_pool[l], cache_win_k[l], cache_win_v[l],
            cache_mem_k[l], cache_mem_v[l], state_conv[l], prm)
        s_pool.append(pool_st_s); s_k.append(ks_new); s_v.append(vs_new); s_conv.append(conv_st_s)
    return (xp, xs,
            jnp.stack(p_pool), jnp.stack(p_k), jnp.stack(p_v), jnp.stack(p_mk), jnp.stack(p_mv), jnp.stack(p_conv),
            jnp.stack(s_pool), jnp.stack(s_k), jnp.stack(s_v), jnp.stack(s_conv))
```

```cpp
#include <hip/hip_runtime.h>
#include <hip/hip_cooperative_groups.h>
#include <cstdio>
#include <cstdint>
namespace cg = cooperative_groups;

#ifndef MK_COOP
#define MK_COOP 1
#endif
#ifndef PHMASK
#define PHMASK 0x3fff
#endif

#define LAS __attribute__((address_space(3)))
typedef unsigned short bf16_t;
typedef short bf16x8 __attribute__((ext_vector_type(8)));
typedef float f32x4 __attribute__((ext_vector_type(4)));
typedef float f32x16 __attribute__((ext_vector_type(16)));
typedef unsigned u32x4 __attribute__((ext_vector_type(4)));
typedef unsigned u32x2 __attribute__((ext_vector_type(2)));
typedef short s16x4 __attribute__((ext_vector_type(4)));
typedef float f32x2_t __attribute__((ext_vector_type(2)));
typedef __bf16 bf16x2_t __attribute__((ext_vector_type(2)));

constexpr int T = 16384, D = 2048, NS = 128, MR = T + NS, MP = 16640;
constexpr int INW = 4096, PW = 1024, AW = 1024, FF = 5632, MEMW = 512, NMEM = 256, NH = 8, HD = 128;
constexpr float EPS = 1e-6f;
constexpr size_t O_Y = 0, O_YS = (size_t)T * D, O_PSP = O_YS + (size_t)NS * D, O_PWK = O_PSP + 15 * 1024, O_PWV = O_PWK + 2048 * 1024,
                 O_PMK = O_PWV + 2048 * 1024, O_PMV = O_PMK + 256 * 512, O_PSC = O_PMV + 256 * 512, O_SSP = O_PSC + 2 * FF,
                 O_SWK = O_SSP + 32 * 15 * 1024, O_SWV = O_SWK + 32 * 4 * 1024, O_SSC = O_SWV + 32 * 4 * 1024, O_END = O_SSC + 32 * 2 * FF;
constexpr size_t MiB = 1u << 20;
constexpr size_t WS_WIN = 1 * MiB, WS_WOUT = 17 * MiB, WS_WMQ = 25 * MiB, WS_WMKV = 27 * MiB, WS_WMO = 31 * MiB, WS_WGU = 33 * MiB, WS_WDN = 77 * MiB,
                 WS_WPOOL = 99 * MiB, WS_MK = WS_WPOOL + 512 * 1024, WS_MV = WS_MK + 256 * 1024, WS_MN = 100 * MiB, WS_MEMKV = 101 * MiB,
                 WS_CMK = 102 * MiB, WS_CMV = 110 * MiB, WS_LSE = 118 * MiB, WS_H = 120 * MiB, WS_XRES = 185 * MiB, WS_QM = 315 * MiB, WS_OM = 332 * MiB,
                 WS_PROJ = 349 * MiB, WS_QN = 479 * MiB, WS_KN = 512 * MiB, WS_DIFF = 545 * MiB, WS_MIXED = 578 * MiB, WS_OP = 643 * MiB, WS_END = 741 * MiB,
                 WS_G = 349 * MiB, WS_UP = 528 * MiB;
static_assert(WS_UP + (size_t)MP * FF * 2 <= WS_END && WS_G + (size_t)MP * FF * 2 <= WS_UP, "ws map");
constexpr size_t WS_FG = 741 * MiB, WS_FU = 744 * MiB, WS_LG = 747 * MiB, WS_END2 = 750 * MiB;
constexpr size_t WS_BAR = 752 * MiB, WS_BAR_BYTES = 16384, WS_END4 = 753 * MiB;
constexpr size_t WS_SSQ1 = WS_LSE + 1792 * 1024, WS_SSQ2 = WS_SSQ1 + 128 * 1024;
static_assert(3 * (size_t)MP * 8 * 4 <= 1792 * 1024, "lse");
constexpr int LDS_BYTES = 147456;

__device__ const double INVF[64] = {
1.0, 0.8659643233600653, 0.7498942093324559, 0.6493816315762113,
0.5623413251903491, 0.4869675251658631, 0.4216965034285822, 0.3651741272548377,
0.31622776601683794, 0.27384196342643613, 0.23713737056616552, 0.2053525026457146,
0.1778279410038923, 0.1539926526059492, 0.1333521432163324, 0.11547819846894582,
0.1, 0.08659643233600653, 0.07498942093324558, 0.06493816315762113,
0.05623413251903491, 0.04869675251658631, 0.042169650342858224, 0.03651741272548377,
0.03162277660168379, 0.027384196342643614, 0.023713737056616554, 0.02053525026457146,
0.01778279410038923, 0.01539926526059492, 0.01333521432163324, 0.011547819846894581,
0.01, 0.008659643233600654, 0.007498942093324558, 0.006493816315762113,
0.005623413251903491, 0.004869675251658631, 0.004216965034285823, 0.003651741272548377,
0.0031622776601683794, 0.0027384196342643613, 0.0023713737056616554, 0.002053525026457146,
0.0017782794100389228, 0.001539926526059492, 0.001333521432163324, 0.0011547819846894581,
0.001, 0.0008659643233600654, 0.0007498942093324559, 0.0006493816315762113,
0.0005623413251903491, 0.0004869675251658631, 0.00042169650342858224, 0.0003651741272548377,
0.00031622776601683794, 0.0002738419634264361, 0.00023713737056616554, 0.0002053525026457146,
0.00017782794100389227, 0.0001539926526059492, 0.0001333521432163324, 0.00011547819846894582};

__device__ __forceinline__ float bf2f(unsigned b) { return __uint_as_float(b << 16); }
__device__ __forceinline__ unsigned pk2(float lo, float hi) { f32x2_t v = {lo, hi}; bf16x2_t b = __builtin_convertvector(v, bf16x2_t); return __builtin_bit_cast(unsigned, b); }
__device__ __forceinline__ float wave_sum(float v) {
#pragma unroll
    for (int o = 1; o < 64; o <<= 1) v += __shfl_xor(v, o);
    return v;
}
__device__ __forceinline__ void unpack8(u32x4 w, float* f) {
    f[0] = bf2f(w.x & 0xffffu); f[1] = bf2f(w.x >> 16); f[2] = bf2f(w.y & 0xffffu); f[3] = bf2f(w.y >> 16);
    f[4] = bf2f(w.z & 0xffffu); f[5] = bf2f(w.z >> 16); f[6] = bf2f(w.w & 0xffffu); f[7] = bf2f(w.w >> 16);
}
__device__ __forceinline__ u32x4 pack8(const float* f) { u32x4 o; o.x = pk2(f[0], f[1]); o.y = pk2(f[2], f[3]); o.z = pk2(f[4], f[5]); o.w = pk2(f[6], f[7]); return o; }
#define LDS_WAIT() asm volatile("s_waitcnt lgkmcnt(0)" ::: "memory")

namespace pg8 {
constexpr int BM = 256, BK = 64, HALF = 128, HTB = HALF * BK * 2, STAGE_BYTES = 8 * HTB, NXCD = 8, WGM = 8;
__host__ __device__ __forceinline__ int lds_byte(int r, int c) { const int st = (r >> 4) * 2 + (c >> 5), rr = r & 15, cc = c & 31, ob = rr * 64 + cc * 2; return st * 1024 + (ob ^ (((ob >> 9) & 1) << 5)); }
__host__ __device__ __forceinline__ void stage_rc(int b, int& R, int& C) { const int st = b / 1024, sb = b % 1024, swz = sb ^ (((sb >> 9) & 1) << 5); R = (st >> 1) * 16 + swz / 64; C = (st & 1) * 32 + (swz % 64) / 2; }
__host__ __device__ __forceinline__ int perm32(int rho) { const int n = rho >> 4, i = rho & 15; return 8 * (i >> 2) + 4 * n + (i & 3); }
struct Unit { int pm, pn; };
struct Gemm { const bf16_t* A; const bf16_t* Bt; int lda, ldb, K; long a_pn_off; };
struct StaticOrder {
    int nM, nN, nwg, G, c;
    __host__ __device__ void init(int M, int N, int G_, int c_) { nM = M / BM; nN = N / BM; nwg = nM * nN; G = G_; c = c_; }
    __host__ __device__ bool next(int i, Unit& u) const {
        const long L = (long)i * G + c; if (L >= nwg) return false;
        int wgid = (int)L; { const int q = nwg / NXCD, r = nwg % NXCD, xcd = wgid % NXCD, off = wgid / NXCD; wgid = (xcd < r ? xcd * (q + 1) : r * (q + 1) + (xcd - r) * q) + off; }
        const int nig = WGM * nN, gid = wgid / nig, fm = gid * WGM, gsz = (nM - fm) < WGM ? (nM - fm) : WGM;
        u.pm = fm + ((wgid % nig) % gsz); u.pn = (wgid % nig) / gsz; return true;
    }
};
struct EpiBf16 {
    static constexpr bool PERM = true;
    bf16_t* O; int ldc;
    __device__ __forceinline__ void operator()(const f32x4 (&acc)[2][2][4][2], const Unit& u, int wr, int wc, int fr, int fq) const {
        const int row0 = u.pm * BM + wr * 64 + fr, col0 = u.pn * BM + wc * 32 + 8 * fq;
#pragma unroll
        for (int ai = 0; ai < 2; ++ai)
#pragma unroll
            for (int m = 0; m < 4; ++m) { bf16_t* rowp = O + (size_t)(row0 + ai * HALF + m * 16) * ldc + col0;
#pragma unroll
                for (int bj = 0; bj < 2; ++bj) { const f32x4 v0 = acc[ai][bj][m][0], v1 = acc[ai][bj][m][1];
                    u32x4 w; w.x = pk2(v0[0], v0[1]); w.y = pk2(v0[2], v0[3]); w.z = pk2(v1[0], v1[1]); w.w = pk2(v1[2], v1[3]);
                    *(u32x4*)(rowp + bj * HALF) = w; } }
    }
};
struct EpiGU {
    static constexpr bool PERM = true;
    bf16_t* G; bf16_t* UP; const float* ssq;
    __device__ __forceinline__ void operator()(const f32x4 (&acc)[2][2][4][2], const Unit& u, int wr, int wc, int fr, int fq) const {
        const int row0 = u.pm * BM + wr * 64 + fr, col0 = u.pn * HALF + wc * 32 + 8 * fq;
#pragma unroll
        for (int ai = 0; ai < 2; ++ai)
#pragma unroll
            for (int m = 0; m < 4; ++m) { const size_t off = (size_t)(row0 + ai * HALF + m * 16) * FF + col0; const f32x4 q0 = *(const f32x4*)(ssq + (size_t)(row0 + ai * HALF + m * 16) * 8), q1 = *(const f32x4*)(ssq + (size_t)(row0 + ai * HALF + m * 16) * 8 + 4); const float rs = rsqrtf(((q0.x + q0.y) + (q0.z + q0.w) + (q1.x + q1.y) + (q1.z + q1.w)) * (1.f / D) + EPS);
#pragma unroll
                for (int bj = 0; bj < 2; ++bj) { const f32x4 v0 = acc[ai][bj][m][0] * rs, v1 = acc[ai][bj][m][1] * rs;
                    u32x4 w; w.x = pk2(v0[0], v0[1]); w.y = pk2(v0[2], v0[3]); w.z = pk2(v1[0], v1[1]); w.w = pk2(v1[2], v1[3]);
                    *(u32x4*)((bj ? UP : G) + off) = w; } }
    }
};
struct EpiF32 {
    static constexpr bool PERM = false;
    float* O; int ldc;
    __device__ __forceinline__ void operator()(const f32x4 (&acc)[2][2][4][2], const Unit& u, int wr, int wc, int fr, int fq) const {
        const int row0 = u.pm * BM + wr * 64 + fr, col0 = u.pn * BM + wc * 32 + 4 * fq;
#pragma unroll
        for (int ai = 0; ai < 2; ++ai)
#pragma unroll
            for (int m = 0; m < 4; ++m) { float* rowp = O + (size_t)(row0 + ai * HALF + m * 16) * ldc + col0;
#pragma unroll
                for (int bj = 0; bj < 2; ++bj)
#pragma unroll
                    for (int n = 0; n < 2; ++n) *(f32x4*)(rowp + bj * HALF + n * 16) = acc[ai][bj][m][n]; }
    }
};
struct EpiRes {
    static constexpr bool PERM = false;
    const float* base0; const float* base1; int split; float* out; int nrows;
    __device__ __forceinline__ void operator()(const f32x4 (&acc)[2][2][4][2], const Unit& u, int wr, int wc, int fr, int fq) const {
        const int row0 = u.pm * BM + wr * 64 + fr, col0 = u.pn * BM + wc * 32 + 4 * fq;
#pragma unroll
        for (int ai = 0; ai < 2; ++ai)
#pragma unroll
            for (int m = 0; m < 4; ++m) { const int row = row0 + ai * HALF + m * 16;
                if (row < nrows) {
                    const float* bp = (row < split ? base0 + (size_t)row * D : base1 + (size_t)(row - split) * D) + col0; float* op = out + (size_t)row * D + col0;
#pragma unroll
                    for (int bj = 0; bj < 2; ++bj)
#pragma unroll
                        for (int n = 0; n < 2; ++n) { const f32x4 b = *(const f32x4*)(bp + bj * HALF + n * 16); *(f32x4*)(op + bj * HALF + n * 16) = b + acc[ai][bj][m][n]; } } }
    }
};

__device__ __forceinline__ float dpp_ror1(float x) { return __int_as_float(__builtin_amdgcn_update_dpp(0, __float_as_int(x), 0x121, 0xf, 0xf, false)); }
__device__ __forceinline__ float dpp_ror2(float x) { return __int_as_float(__builtin_amdgcn_update_dpp(0, __float_as_int(x), 0x122, 0xf, 0xf, false)); }
struct EpiGUConv {
    static constexpr bool PERM = true;
    bf16_t* ACT; const float* pssq; const float* cw; const float* cb; float* firstg; float* firstup; float* lastg; LAS float* X;
    __device__ __forceinline__ float rsq(int row) const { const f32x4 q0 = *(const f32x4*)(pssq + (size_t)row * 8), q1 = *(const f32x4*)(pssq + (size_t)row * 8 + 4);
        return rsqrtf(((q0.x + q0.y) + (q0.z + q0.w) + (q1.x + q1.y) + (q1.z + q1.w)) * (1.f / D) + EPS); }
    __device__ __forceinline__ void operator()(const f32x4 (&acc)[2][2][4][2], const Unit& u, int wr, int wc, int fr, int fq) const {
        const int ch0 = u.pn * HALF + wc * 32 + 8 * fq, rowb = u.pm * BM + wr * 64 + fr;
        f32x4 w0[2], w1[2], w2[2], bb[2];
#pragma unroll
        for (int n = 0; n < 2; ++n) { w0[n] = *(const f32x4*)(cw + ch0 + 4 * n); w1[n] = *(const f32x4*)(cw + FF + ch0 + 4 * n); w2[n] = *(const f32x4*)(cw + 2 * FF + ch0 + 4 * n); bb[n] = *(const f32x4*)(cb + ch0 + 4 * n); }
#pragma unroll
        for (int ai = 0; ai < 2; ++ai) { const float rs = rsq(rowb + ai * HALF + 48);
            if (fr >= 14) {
#pragma unroll
                for (int n = 0; n < 2; ++n) *(LAS f32x4*)(X + ((((ai * 2 + wr) * 4 + wc) * 2 + (fr - 14)) * 32 + 8 * fq + 4 * n)) = acc[ai][0][3][n] * rs; } }
        asm volatile("s_waitcnt lgkmcnt(0)" ::: "memory"); __builtin_amdgcn_s_barrier(); asm volatile("" ::: "memory");
#pragma unroll
        for (int ai = 0; ai < 2; ++ai) {
            f32x4 gprev[2];
            if (wr == 1 || ai == 1) { const int sai = (wr == 1) ? ai : ai - 1, swr = (wr == 1) ? 0 : 1; const LAS float* xp = X + (((sai * 2 + swr) * 4 + wc) * 2) * 32 + 8 * fq;
#pragma unroll
                for (int n = 0; n < 2; ++n) { const f32x4 h2 = *(const LAS f32x4*)(xp + 4 * n), h1 = *(const LAS f32x4*)(xp + 32 + 4 * n); gprev[n] = (fr == 15) ? h1 : h2; } }
            else { gprev[0] = (f32x4){0.f, 0.f, 0.f, 0.f}; gprev[1] = gprev[0]; }
#pragma unroll
            for (int m = 0; m < 4; ++m) { const int row = rowb + ai * HALF + m * 16; const float rs = rsq(row);
                f32x4 g[2], a[2];
#pragma unroll
                for (int n = 0; n < 2; ++n) { g[n] = acc[ai][0][m][n] * rs; const f32x4 up = acc[ai][1][m][n] * rs;
#pragma unroll
                    for (int e = 0; e < 4; ++e) { const float r1c = dpp_ror1(g[n][e]), r1p = dpp_ror1(gprev[n][e]), r2c = dpp_ror2(g[n][e]), r2p = dpp_ror2(gprev[n][e]);
                        const float p1 = fr >= 1 ? r1c : r1p, p2 = fr >= 2 ? r2c : r2p;
                        const float c = bb[n][e] + w0[n][e] * p2 + w1[n][e] * p1 + w2[n][e] * g[n][e]; a[n][e] = c / (1.f + __expf(-c)) * up[e]; }
                    if (ai == 0 && m == 0 && wr == 0 && fr < 2) { *(f32x4*)(firstg + ((size_t)u.pm * 2 + fr) * FF + ch0 + 4 * n) = g[n]; *(f32x4*)(firstup + ((size_t)u.pm * 2 + fr) * FF + ch0 + 4 * n) = up; }
                    if (ai == 1 && m == 3 && wr == 1 && fr >= 14) *(f32x4*)(lastg + ((size_t)u.pm * 2 + (fr - 14)) * FF + ch0 + 4 * n) = g[n]; }
                if (!(ai == 0 && m == 0 && wr == 0 && fr < 2)) { u32x4 w; w.x = pk2(a[0][0], a[0][1]); w.y = pk2(a[0][2], a[0][3]); w.z = pk2(a[1][0], a[1][1]); w.w = pk2(a[1][2], a[1][3]);
                    *(u32x4*)(ACT + (size_t)row * FF + ch0) = w; }
                gprev[0] = g[0]; gprev[1] = g[1]; }
        }
    }
};

struct EpiResN {
    static constexpr bool PERM = false;
    const float* base; float* out; bf16_t* xb; float* pssq; LAS float* sred;
    __device__ __forceinline__ void operator()(const f32x4 (&acc)[2][2][4][2], const Unit& u, int wr, int wc, int fr, int fq) const {
        const int row0 = u.pm * BM + wr * 64 + fr, col0 = u.pn * BM + wc * 32 + 4 * fq;
#pragma unroll
        for (int ai = 0; ai < 2; ++ai)
#pragma unroll
            for (int m = 0; m < 4; ++m) { const int row = row0 + ai * HALF + m * 16;
                const float* bp = base + (size_t)row * D + col0; float* op = out + (size_t)row * D + col0; bf16_t* xp = xb + (size_t)row * D + col0;
                float ss = 0.f;
#pragma unroll
                for (int bj = 0; bj < 2; ++bj)
#pragma unroll
                    for (int n = 0; n < 2; ++n) { const f32x4 b = *(const f32x4*)(bp + bj * HALF + n * 16); const f32x4 x = b + acc[ai][bj][m][n]; *(f32x4*)(op + bj * HALF + n * 16) = x;
                        u32x2 w; w.x = pk2(x.x, x.y); w.y = pk2(x.z, x.w); *(u32x2*)(xp + bj * HALF + n * 16) = w; ss += (x.x * x.x + x.y * x.y) + (x.z * x.z + x.w * x.w); }
                ss += __shfl_xor(ss, 16); ss += __shfl_xor(ss, 32);
                if (fq == 0) sred[wc * 256 + ai * HALF + wr * 64 + m * 16 + fr] = ss; }
        asm volatile("s_waitcnt lgkmcnt(0)" ::: "memory"); __builtin_amdgcn_s_barrier(); asm volatile("" ::: "memory");
        const int t = threadIdx.x;
        if (t < 256) pssq[(size_t)(u.pm * BM + t) * 8 + u.pn] = (sred[t] + sred[256 + t]) + (sred[512 + t] + sred[768 + t]);
    }
};

template <class Epi, class Sched>
__device__ __forceinline__ void gemm_phase(LAS unsigned char* lds, const Gemm g, const Sched& S, const Epi& E) {
    const int tid = threadIdx.x, wid = __builtin_amdgcn_readfirstlane(tid >> 6), lane = tid & 63, wr = wid >> 2, wc = wid & 3, fr = lane & 15, fq = lane >> 4;
    const int K = g.K, nt = K / BK;
    unsigned voffA[2], voffB[2];
#pragma unroll
    for (int i = 0; i < 2; ++i) { int R, C; stage_rc(tid * 16 + i * 8192, R, C); const int Rb = Epi::PERM ? ((R & ~31) + perm32(R & 31)) : R;
        voffA[i] = (unsigned)(R * g.lda + C) * 2u; voffB[i] = (unsigned)(Rb * g.ldb + C) * 2u; }
    const size_t kstep = (size_t)(BK * 2);
    const size_t hstepA = (size_t)HALF * g.lda * 2, hstepB = (size_t)HALF * g.ldb * 2;
    const size_t tstepA = 2 * hstepA, tstepB = 2 * hstepB;
    const unsigned ldsw = (unsigned)wid * 1024u;
    const int aoff = lds_byte(wr * 64 + fr, fq * 8), boff = lds_byte(wc * 32 + fr, fq * 8);
#define PG8_SA(b, h) (((b) * 2 + (h)) * HTB)
#define PG8_SB(b, h) ((4 + (b) * 2 + (h)) * HTB)
#define PG8_STAGE(bufoff, gbase, voff) do { _Pragma("unroll") for (int _i = 0; _i < 2; ++_i) \
        __builtin_amdgcn_global_load_lds((const unsigned*)((const char*)(gbase) + (voff)[_i]), (LAS unsigned*)(lds + (bufoff) + ldsw + _i * 8192), 16, 0, 0); } while (0)
#define PG8_LDA(dst, b, h) do { _Pragma("unroll") for (int m = 0; m < 4; ++m) _Pragma("unroll") for (int k = 0; k < 2; ++k) dst[m][k] = *(const LAS bf16x8*)(lds + PG8_SA(b, h) + aoff + m * 2048 + k * 1024); } while (0)
#define PG8_LDB(dst, b, h) do { _Pragma("unroll") for (int n = 0; n < 2; ++n) _Pragma("unroll") for (int k = 0; k < 2; ++k) dst[n][k] = *(const LAS bf16x8*)(lds + PG8_SB(b, h) + boff + n * 2048 + k * 1024); } while (0)
#define PG8_MMA(ai, bj, At, Bt) do { __builtin_amdgcn_s_setprio(1); _Pragma("unroll") for (int m = 0; m < 4; ++m) _Pragma("unroll") for (int n = 0; n < 2; ++n) _Pragma("unroll") for (int k = 0; k < 2; ++k) \
        acc[ai][bj][m][n] = __builtin_amdgcn_mfma_f32_16x16x32_bf16(Bt[n][k], At[m][k], acc[ai][bj][m][n], 0, 0, 0); __builtin_amdgcn_s_setprio(0); } while (0)
#define PG8_WAIT_V(n) asm volatile("s_waitcnt vmcnt(" #n ")" ::: "memory")
#define PG8_WAIT_L(n) asm volatile("s_waitcnt lgkmcnt(" #n ")" ::: "memory")
#define PG8_BAR __builtin_amdgcn_s_barrier()
#define PG8_SCHED __builtin_amdgcn_sched_barrier(0)
    Unit cur, nxt; int ui = 0;
    if (!S.next(0, cur)) return;
    f32x4 acc[2][2][4][2];
#pragma unroll
    for (int a = 0; a < 2; ++a)
#pragma unroll
        for (int b = 0; b < 2; ++b)
#pragma unroll
            for (int m = 0; m < 4; ++m)
#pragma unroll
                for (int n = 0; n < 2; ++n) acc[a][b][m][n] = (f32x4){0.f, 0.f, 0.f, 0.f};
    bf16x8 At[4][2], B0[2][2], B1[2][2];
    const char* cA = (const char*)g.A + (size_t)cur.pm * tstepA + (size_t)cur.pn * g.a_pn_off; const char* cB = (const char*)g.Bt + (size_t)cur.pn * tstepB;
    PG8_STAGE(PG8_SB(0, 0), cB, voffB); PG8_STAGE(PG8_SB(0, 1), cB + hstepB, voffB); PG8_STAGE(PG8_SA(0, 0), cA, voffA); PG8_STAGE(PG8_SA(0, 1), cA + hstepA, voffA);
    if (wr == 1) PG8_BAR;
    PG8_WAIT_V(2); PG8_BAR;
    PG8_STAGE(PG8_SB(1, 0), cB + kstep, voffB); PG8_STAGE(PG8_SA(1, 0), cA + kstep, voffA); PG8_STAGE(PG8_SB(1, 1), cB + hstepB + kstep, voffB);
    PG8_WAIT_V(6); PG8_BAR;
    for (;;) {
        const bool has_next = S.next(ui + 1, nxt);
        const char* nA = has_next ? (const char*)g.A + (size_t)nxt.pm * tstepA + (size_t)nxt.pn * g.a_pn_off : cA; const char* nB = has_next ? (const char*)g.Bt + (size_t)nxt.pn * tstepB : cB;
        for (int t = 0; t < nt; t += 2) {
            const bool last = (t == nt - 2);
            const char* a1 = cA + (size_t)(t + 1) * kstep;
            const char* a2 = last ? nA : cA + (size_t)(t + 2) * kstep; const char* b2 = last ? nB : cB + (size_t)(t + 2) * kstep;
            const char* a3 = a2 + kstep; const char* b3 = b2 + kstep;
            PG8_LDB(B0, 0, 0); PG8_LDB(B1, 0, 1); PG8_SCHED; PG8_LDA(At, 0, 0); PG8_STAGE(PG8_SA(1, 1), a1 + hstepA, voffA);
            PG8_WAIT_V(8); PG8_WAIT_L(0); PG8_BAR; PG8_MMA(0, 0, At, B0); PG8_MMA(0, 1, At, B1); PG8_BAR; PG8_SCHED;
            PG8_LDA(At, 0, 1); PG8_STAGE(PG8_SB(0, 0), b2, voffB); PG8_STAGE(PG8_SB(0, 1), b2 + hstepB, voffB); PG8_STAGE(PG8_SA(0, 0), a2, voffA);
            PG8_WAIT_V(8); PG8_WAIT_L(0); PG8_BAR; PG8_MMA(1, 0, At, B0); PG8_MMA(1, 1, At, B1); PG8_BAR; PG8_SCHED;
            PG8_LDB(B0, 1, 0); PG8_LDB(B1, 1, 1); PG8_SCHED; PG8_LDA(At, 1, 0); PG8_STAGE(PG8_SA(0, 1), a2 + hstepA, voffA);
            PG8_WAIT_V(8); PG8_WAIT_L(0); PG8_BAR; PG8_MMA(0, 0, At, B0); PG8_MMA(0, 1, At, B1); PG8_BAR; PG8_SCHED;
            PG8_LDA(At, 1, 1); PG8_STAGE(PG8_SB(1, 0), b3, voffB); PG8_STAGE(PG8_SB(1, 1), b3 + hstepB, voffB); PG8_STAGE(PG8_SA(1, 0), a3, voffA);
            PG8_WAIT_V(8); PG8_WAIT_L(0); PG8_BAR; PG8_MMA(1, 0, At, B0); PG8_MMA(1, 1, At, B1); PG8_BAR; PG8_SCHED;
        }
        if (wr == 0) PG8_BAR;
        E(acc, cur, wr, wc, fr, fq);
        if (!has_next) break;
#pragma unroll
        for (int a = 0; a < 2; ++a)
#pragma unroll
            for (int b = 0; b < 2; ++b)
#pragma unroll
                for (int m = 0; m < 4; ++m)
#pragma unroll
                    for (int n = 0; n < 2; ++n) acc[a][b][m][n] = (f32x4){0.f, 0.f, 0.f, 0.f};
        cur = nxt; cA = nA; cB = nB; ++ui;
        if (wr == 1) PG8_BAR;
    }
    PG8_WAIT_V(0);
    PG8_BAR;
#undef PG8_SA
#undef PG8_SB
#undef PG8_STAGE
#undef PG8_LDA
#undef PG8_LDB
#undef PG8_MMA
#undef PG8_WAIT_V
#undef PG8_WAIT_L
#undef PG8_BAR
#undef PG8_SCHED
}
}


template <int NT, class Epi>
__device__ __forceinline__ void skinny_gemm_nt(LAS unsigned char* lds, const bf16_t* A, int lda, const bf16_t* Wt, int ldb, int K, int nct, int nrh, int bx, int G, int wave, int lane, int tid, const Epi& E) {
    LAS float* red = (LAS float*)lds;
    const int fr = lane & 15, fq = lane >> 4, kw = K / 8, ngrp = (nct + NT - 1) / NT;
    for (int item = bx; item < ngrp * nrh; item += G) {
        const int ctg = item % ngrp, rh = item / ngrp;
        f32x4 acc[NT][8];
#pragma unroll
        for (int t = 0; t < NT; ++t)
#pragma unroll
            for (int rb = 0; rb < 8; ++rb) acc[t][rb] = (f32x4){0.f, 0.f, 0.f, 0.f};
        const bf16_t* bpt[NT];
#pragma unroll
        for (int t = 0; t < NT; ++t) { const int ctt = ctg * NT + t < nct ? ctg * NT + t : nct - 1; bpt[t] = Wt + (size_t)(ctt * 16 + fr) * ldb + wave * kw + fq * 8; }
        const bf16_t* ap = A + (size_t)(rh * 128 + fr) * lda + wave * kw + fq * 8;
        bf16x8 b[NT], a[8];
#pragma unroll
        for (int t = 0; t < NT; ++t) b[t] = *(const bf16x8*)(bpt[t]);
#pragma unroll
        for (int rb = 0; rb < 8; ++rb) a[rb] = *(const bf16x8*)(ap + (size_t)rb * 16 * lda);
        for (int k = 0; k < kw; k += 32) {
            bf16x8 nb[NT], na[8];
#pragma unroll
            for (int t = 0; t < NT; ++t) nb[t] = b[t];
#pragma unroll
            for (int rb = 0; rb < 8; ++rb) na[rb] = a[rb];
            if (k + 32 < kw) {
#pragma unroll
                for (int t = 0; t < NT; ++t) nb[t] = *(const bf16x8*)(bpt[t] + k + 32);
#pragma unroll
                for (int rb = 0; rb < 8; ++rb) na[rb] = *(const bf16x8*)(ap + (size_t)rb * 16 * lda + k + 32);
            }
#pragma unroll
            for (int t = 0; t < NT; ++t)
#pragma unroll
                for (int rb = 0; rb < 8; ++rb) acc[t][rb] = __builtin_amdgcn_mfma_f32_16x16x32_bf16(a[rb], b[t], acc[t][rb], 0, 0, 0);
#pragma unroll
            for (int t = 0; t < NT; ++t) b[t] = nb[t];
#pragma unroll
            for (int rb = 0; rb < 8; ++rb) a[rb] = na[rb];
        }
#pragma unroll
        for (int t = 0; t < NT; ++t) {
#pragma unroll
            for (int rb = 0; rb < 8; ++rb)
#pragma unroll
                for (int j = 0; j < 4; ++j) red[(wave * 128 + rb * 16 + 4 * fq + j) * 16 + fr] = acc[t][rb][j];
            __syncthreads();
            if (ctg * NT + t < nct) { const int e = tid * 4, row = e >> 4, col = e & 15;
                f32x4 v = *(const LAS f32x4*)(red + row * 16 + col);
#pragma unroll
                for (int w = 1; w < 8; ++w) v += *(const LAS f32x4*)(red + (w * 128 + row) * 16 + col);
                E(row, rh, (ctg * NT + t) * 16 + col, v); }
            __syncthreads();
        }
    }
}
template <int RB = 8, class Epi>
__device__ __forceinline__ void skinny_gemm(LAS unsigned char* lds, const bf16_t* A, int lda, const bf16_t* Wt, int ldb, int K, int nct, int nrh, int bx, int G, int wave, int lane, int tid, const Epi& E) {
    LAS float* red = (LAS float*)lds;
    const int fr = lane & 15, fq = lane >> 4, kw = K / 8;
    for (int item = bx; item < nct * nrh * (8 / RB); item += G) {
        const int ct = item % nct, rs = item / nct, row0 = rs * RB * 16, rh = row0 >> 7, rin = row0 & 127;
        f32x4 acc[RB];
#pragma unroll
        for (int rb = 0; rb < RB; ++rb) acc[rb] = (f32x4){0.f, 0.f, 0.f, 0.f};
        const bf16_t* bp = Wt + (size_t)(ct * 16 + fr) * ldb + wave * kw + fq * 8;
        const bf16_t* ap = A + (size_t)(row0 + fr) * lda + wave * kw + fq * 8;
        bf16x8 b0 = *(const bf16x8*)(bp), b1 = *(const bf16x8*)(bp + 32), a0[RB], a1[RB];
#pragma unroll
        for (int rb = 0; rb < RB; ++rb) { a0[rb] = *(const bf16x8*)(ap + (size_t)rb * 16 * lda); a1[rb] = *(const bf16x8*)(ap + (size_t)rb * 16 * lda + 32); }
        for (int k = 0; k < kw; k += 64) {
            bf16x8 nb0 = b0, nb1 = b1, na0[RB], na1[RB];
#pragma unroll
            for (int rb = 0; rb < RB; ++rb) { na0[rb] = a0[rb]; na1[rb] = a1[rb]; }
            if (k + 64 < kw) {
                nb0 = *(const bf16x8*)(bp + k + 64); nb1 = *(const bf16x8*)(bp + k + 96);
#pragma unroll
                for (int rb = 0; rb < RB; ++rb) { na0[rb] = *(const bf16x8*)(ap + (size_t)rb * 16 * lda + k + 64); na1[rb] = *(const bf16x8*)(ap + (size_t)rb * 16 * lda + k + 96); }
            }
#pragma unroll
            for (int rb = 0; rb < RB; ++rb) acc[rb] = __builtin_amdgcn_mfma_f32_16x16x32_bf16(a0[rb], b0, acc[rb], 0, 0, 0);
#pragma unroll
            for (int rb = 0; rb < RB; ++rb) acc[rb] = __builtin_amdgcn_mfma_f32_16x16x32_bf16(a1[rb], b1, acc[rb], 0, 0, 0);
            b0 = nb0; b1 = nb1;
#pragma unroll
            for (int rb = 0; rb < RB; ++rb) { a0[rb] = na0[rb]; a1[rb] = na1[rb]; }
        }
#pragma unroll
        for (int rb = 0; rb < RB; ++rb)
#pragma unroll
            for (int j = 0; j < 4; ++j) red[(wave * (RB * 16) + rb * 16 + 4 * fq + j) * 16 + fr] = acc[rb][j];
        __syncthreads();
        if (tid < RB * 64) { const int e = tid * 4, row = e >> 4, col = e & 15;
            f32x4 v = *(const LAS f32x4*)(red + row * 16 + col);
#pragma unroll
            for (int w = 1; w < 8; ++w) v += *(const LAS f32x4*)(red + (w * (RB * 16) + row) * 16 + col);
            E(rin + row, rh, ct * 16 + col, v); }
        __syncthreads();
    }
}
struct SkBf16 { bf16_t* O; int ldc; __device__ __forceinline__ void operator()(int row, int rh, int col, f32x4 v) const { u32x2 w; w.x = pk2(v.x, v.y); w.y = pk2(v.z, v.w); *(u32x2*)(O + (size_t)(rh * 128 + row) * ldc + col) = w; } };
struct SkF32 { float* O; int ldc; __device__ __forceinline__ void operator()(int row, int rh, int col, f32x4 v) const { *(f32x4*)(O + (size_t)(rh * 128 + row) * ldc + col) = v; } };
struct SkRes { const float* base; float* O; __device__ __forceinline__ void operator()(int row, int rh, int col, f32x4 v) const { const f32x4 b = *(const f32x4*)(base + (size_t)row * D + col); *(f32x4*)(O + (size_t)row * D + col) = b + v; } };
struct SkResN { const float* base; float* O; bf16_t* xb; float* ssq; __device__ __forceinline__ void operator()(int row, int rh, int col, f32x4 v) const { const f32x4 b = *(const f32x4*)(base + (size_t)row * D + col); const f32x4 x = b + v;
    *(f32x4*)(O + (size_t)row * D + col) = x; u32x2 w; w.x = pk2(x.x, x.y); w.y = pk2(x.z, x.w); *(u32x2*)(xb + (size_t)row * D + col) = w; float ss = (x.x * x.x + x.y * x.y) + (x.z * x.z + x.w * x.w); ss += __shfl_xor(ss, 1); ss += __shfl_xor(ss, 2); if ((col & 15) == 0) atomicAdd(ssq + row, ss); } };
struct SkGU { bf16_t* Gp; bf16_t* Up; const float* ssq; __device__ __forceinline__ void operator()(int row, int rh, int col, f32x4 v) const { const int ch = (col >> 8) * 128 + (col & 127); v = v * rsqrtf(ssq[row] * (1.f / D) + EPS); u32x2 w; w.x = pk2(v.x, v.y); w.y = pk2(v.z, v.w);
    *(u32x2*)(Gp + (size_t)((col >> 7) & 1) * ((WS_UP - WS_G) / 2) + (size_t)row * FF + ch) = w; } };

typedef __attribute__((address_space(1))) unsigned gu32;
#define RLX_AGENT __ATOMIC_RELAXED, __HIP_MEMORY_SCOPE_AGENT
#define XB_TMO      128
#define XB_XCNT(j)  (256  + 64 * (j))
#define XB_XSUB(j)  (1280 + 64 * (j))
#define XB_XGEN(j)  (2304 + 64 * (j))
#define XB_TOP      3328
#define XB_TOPGEN   3392
#define XCD_BAR_WORDS 3456
#define XB_SPIN_CAP (1u << 18)

__device__ __forceinline__ unsigned xb_ld(unsigned* p)              { return __hip_atomic_load(p, __ATOMIC_RELAXED, __HIP_MEMORY_SCOPE_AGENT); }
__device__ __forceinline__ unsigned xb_add(unsigned* p, unsigned v) { return __hip_atomic_fetch_add(p, v, __ATOMIC_RELAXED, __HIP_MEMORY_SCOPE_AGENT); }
__device__ __forceinline__ unsigned xb_xcc_id() { return (unsigned)__builtin_amdgcn_s_getreg((3 << 11) | 20) & 0xFu; }
#define XB_SPIN(cond, bar) do { unsigned _sp = 0; while (cond) { __builtin_amdgcn_s_sleep(1); \
    if ((++_sp & 255u) == 0u) { if (xb_ld(&(bar)[XB_TMO])) break; if (_sp > XB_SPIN_CAP) { atomicAdd(&(bar)[XB_TMO], 1u); break; } } } } while (0)

struct XcdBarrier {
    unsigned* bar; unsigned x;
    volatile LAS unsigned* st;
};

__device__ __forceinline__ XcdBarrier xcd_barrier_post(unsigned* bar, volatile LAS unsigned* st) {
    XcdBarrier b; b.bar = bar; b.x = xb_xcc_id(); b.st = st;
    if (threadIdx.x == 0) (void)xb_add(&bar[XB_XCNT(b.x)], 1u);
    return b;
}
__device__ __forceinline__ void xcd_barrier_complete(unsigned* bar, unsigned x, unsigned& nloc, unsigned& nx) {
    const unsigned G = gridDim.x * gridDim.y * gridDim.z;
    unsigned sum, cnt, mine, sp = 0u;
    for (;;) {
        sum = 0u; cnt = 0u; mine = 0u;
#pragma unroll
        for (unsigned j = 0; j < 16; ++j) { const unsigned c = xb_ld(&bar[XB_XCNT(j)]); sum += c; cnt += (c > 0u) ? 1u : 0u; mine = (j == x) ? c : mine; }
        if (sum == G) break;
        __builtin_amdgcn_s_sleep(1);
        if ((++sp & 255u) == 0u) { if (xb_ld(&bar[XB_TMO])) break; if (sp > XB_SPIN_CAP) { atomicAdd(&bar[XB_TMO], 1u); break; } }
    }
    nloc = mine > 0u ? mine : 1u; nx = cnt > 0u ? cnt : 1u;
}

__device__ __forceinline__ void xcd_barrier(const XcdBarrier& b) {
    asm volatile("s_waitcnt vmcnt(0)" ::: "memory");
    __syncthreads();
    if (threadIdx.x == 0) {
        unsigned* bar = b.bar;
        __builtin_amdgcn_s_waitcnt(0);
        unsigned nloc = b.st[0], nx = b.st[1];
        if (nloc == 0u) { xcd_barrier_complete(bar, b.x, nloc, nx); b.st[0] = nloc; b.st[1] = nx; }
        const unsigned old = xb_add(&bar[XB_XSUB(b.x)], 1u);
        const unsigned gen = old / nloc;
        if (old + 1u == (gen + 1u) * nloc) {
            __builtin_amdgcn_fence(__ATOMIC_RELEASE, "agent");
            asm volatile("s_waitcnt vmcnt(0)" ::: "memory");
            const unsigned og = xb_add(&bar[XB_TOP], 1u);
            const unsigned tg = og / nx;
            if (og + 1u == (tg + 1u) * nx) xb_add(&bar[XB_TOPGEN], 1u);
            else XB_SPIN(xb_ld(&bar[XB_TOPGEN]) == tg, bar);
            __builtin_amdgcn_fence(__ATOMIC_ACQUIRE, "agent");
            xb_add(&bar[XB_XGEN(b.x)], 1u);
            asm volatile("s_waitcnt vmcnt(0)" ::: "memory");
        } else {
            XB_SPIN(xb_ld(&bar[XB_XGEN(b.x)]) == gen, bar);
            __builtin_amdgcn_fence(__ATOMIC_ACQUIRE, "agent");
            asm volatile("s_waitcnt vmcnt(0)" ::: "memory");
        }
    }
    __syncthreads();
}

struct Args { const float* in[30]; float* out; unsigned char* ws; int ph_lo, ph_hi, coop, pad; };

__device__ __forceinline__ void transpose_item(const float* W, int N, bf16_t* WT, int ldk, int out_row0, int k0, int n0, const float* nscale, const float* kscale, LAS float* scr, int lane) {
    f32x4 v[16];
#pragma unroll
    for (int i = 0; i < 16; ++i) v[i] = *(const f32x4*)(W + (size_t)(k0 + (lane >> 4) + 4 * i) * N + n0 + 4 * (lane & 15));
#pragma unroll
    for (int i = 0; i < 16; ++i) { const int kk = (lane >> 4) + 4 * i; const float ks = kscale ? kscale[k0 + kk] : 1.f;
        *(LAS f32x4*)(scr + kk * 68 + ((4 * (lane & 15)) ^ (4 * ((kk >> 3) & 7)))) = v[i] * ks; }
    LDS_WAIT();
    const int c = lane & 7;
#pragma unroll
    for (int j = 0; j < 8; ++j) { const int n = (lane >> 3) + 8 * j; const LAS float* sp = scr + (8 * c) * 68 + (n ^ (4 * c)); const float sc = nscale ? nscale[out_row0 + n] : 1.f;
        u32x4 o; o.x = pk2(sp[0 * 68] * sc, sp[1 * 68] * sc); o.y = pk2(sp[2 * 68] * sc, sp[3 * 68] * sc); o.z = pk2(sp[4 * 68] * sc, sp[5 * 68] * sc); o.w = pk2(sp[6 * 68] * sc, sp[7 * 68] * sc);
        *(u32x4*)(WT + (size_t)(out_row0 + n) * ldk + k0 + 8 * c) = o; }
    LDS_WAIT();
}
__device__ __forceinline__ void transpose_mat(const float* W, int K, int N, bf16_t* WT, int mode, int row_off, const float* nscale, const float* kscale, int r, LAS float* scr, int lane) {
    const int nnb = N / 64, kb = r / nnb, nb = r % nnb, n0 = nb * 64, k0 = kb * 64;
    const int orow = mode == 0 ? row_off + n0 : (mode == 1 ? (n0 >> 7) * 256 + (n0 & 127) : (n0 >> 7) * 256 + 128 + (n0 & 127));
    transpose_item(W, N, WT, K, orow, k0, n0, nscale, kscale, scr, lane);
}
__device__ __forceinline__ void rms_row(const float* x, const float* gain, bf16_t* o, int lane) {
    f32x4 v[8]; float s = 0.f;
#pragma unroll
    for (int j = 0; j < 8; ++j) { v[j] = ((const f32x4*)x)[lane + 64 * j]; s += (v[j].x * v[j].x + v[j].y * v[j].y) + (v[j].z * v[j].z + v[j].w * v[j].w); }
    const float r = rsqrtf(wave_sum(s) * (1.f / D) + EPS);
#pragma unroll
    for (int j = 0; j < 8; ++j) { const f32x4 gn = ((const f32x4*)gain)[lane + 64 * j]; u32x2 w; w.x = pk2(v[j].x * r * gn.x, v[j].y * r * gn.y); w.y = pk2(v[j].z * r * gn.z, v[j].w * r * gn.w);
        ((u32x2*)o)[lane + 64 * j] = w; }
}

__device__ __forceinline__ int crow(int r, int hi) { return (r & 3) + 8 * (r >> 2) + 4 * hi; }
template <bool F32> __device__ __forceinline__ bf16x8 ld8(const void* p) {
    if constexpr (F32) { const f32x4 a = ((const f32x4*)p)[0], b = ((const f32x4*)p)[1]; u32x4 o; o.x = pk2(a.x, a.y); o.y = pk2(a.z, a.w); o.z = pk2(b.x, b.y); o.w = pk2(b.z, b.w); return __builtin_bit_cast(bf16x8, o); }
    else return *(const bf16x8*)p;
}
struct KVBf16 { static constexpr bool F32 = false; const bf16_t* K; const bf16_t* V; long kp, vp;
    __device__ __forceinline__ const void* kptr(int pos, int e) const { return K + (size_t)pos * kp + e; }
    __device__ __forceinline__ const void* vptr(int pos, int e) const { return V + (size_t)pos * vp + e; } };
struct KVSample { static constexpr bool F32 = true; const float* ck; const float* cv; const float* nk; const float* nv;
    __device__ __forceinline__ const void* kptr(int pos, int e) const { return (pos < 2048 ? ck + (size_t)pos * 1024 : nk + (size_t)(pos - 2048) * 1024) + e; }
    __device__ __forceinline__ const void* vptr(int pos, int e) const { return (pos < 2048 ? cv + (size_t)pos * 1024 : nv + (size_t)(pos - 2048) * 1024) + e; } };
constexpr int VP = 272;

template <class KV, bool MASK, bool QNORM>
__device__ __forceinline__ void att_unit(const KV& kv, int nkb, int p0, int d, int pmax,
        const bf16_t* qbase, long qpitch, int nq, const float* qgain, const float* qssq, int qnp, float scale_log2,
        bf16_t* obase, long opitch, float* lsebase, long lsepitch, LAS unsigned char* vl, int lane) {
    const int qi = lane & 31, hf = lane >> 5;
    const int qic = qi < nq ? qi : nq - 1;
    const bf16_t* qrow = qbase + (size_t)qic * qpitch;
    bf16x8 qf[8];
#pragma unroll
    for (int s = 0; s < 8; ++s) qf[s] = *(const bf16x8*)(qrow + 16 * s + 8 * hf);
    if constexpr (QNORM) {
        float q1s = 0.f; for (int i = 0; i < qnp; ++i) q1s += qssq[qic * qnp + i];
        const float r1 = rsqrtf(q1s * (1.f / D) + EPS);
        float ss = 0.f;
#pragma unroll
        for (int s = 0; s < 8; ++s) { float f[8]; unpack8(__builtin_bit_cast(u32x4, qf[s]), f);
#pragma unroll
            for (int e = 0; e < 8; ++e) { const float t = f[e] * r1; ss += t * t; } }
        ss += __shfl_xor(ss, 32);
        const float r = rsqrtf(ss * (1.f / HD) + EPS) * r1;
#pragma unroll
        for (int s = 0; s < 8; ++s) { float f[8]; unpack8(__builtin_bit_cast(u32x4, qf[s]), f);
#pragma unroll
            for (int e = 0; e < 8; ++e) f[e] = f[e] * r * qgain[16 * s + 8 * hf + e];
            qf[s] = __builtin_bit_cast(bf16x8, pack8(f)); }
    }
    LAS unsigned char* ql = vl + 8 * 32 * VP + qi * VP + hf * 16;
#pragma unroll
    for (int s = 0; s < 8; ++s) *(LAS bf16x8*)(ql + s * 32) = qf[s];
    f32x16 o[4];
#pragma unroll
    for (int mb = 0; mb < 4; ++mb)
#pragma unroll
        for (int r = 0; r < 16; ++r) o[mb][r] = 0.f;
    float m = -1e30f, l = 0.f;
    constexpr bool PIPE = !KV::F32;
    bf16x8 kc[8], vc[8];
    const bf16_t* kp_ = nullptr; const bf16_t* vp_ = nullptr; long kstep_ = 0, vstep_ = 0, vj_ = 0;
    if constexpr (PIPE) {
        kp_ = (const bf16_t*)kv.kptr(0, 0) + (long)(p0 + d * qi) * kv.kp + 8 * hf; kstep_ = (long)32 * d * kv.kp;
        vp_ = (const bf16_t*)kv.vptr(0, 0) + (long)(p0 + d * (lane >> 4)) * kv.vp + (lane & 15) * 8; vstep_ = (long)32 * d * kv.vp; vj_ = (long)4 * d * kv.vp;
#pragma unroll
        for (int s = 0; s < 8; ++s) kc[s] = *(const bf16x8*)(kp_ + 16 * s);
#pragma unroll
        for (int j = 0; j < 8; ++j) vc[j] = *(const bf16x8*)(vp_ + j * vj_);
    }
    for (int kb = 0; kb < nkb; ++kb) {
        if constexpr (!PIPE) {   int pos = p0 + d * (kb * 32 + qi); pos = pos < 0 ? 0 : (pos > pmax ? pmax : pos);
#pragma unroll
            for (int s = 0; s < 8; ++s) kc[s] = ld8<KV::F32>(kv.kptr(pos, 16 * s + 8 * hf));
#pragma unroll
            for (int j = 0; j < 8; ++j) { const int id = lane + 64 * j; int pv = p0 + d * (kb * 32 + (id >> 4)); pv = pv < 0 ? 0 : (pv > pmax ? pmax : pv); vc[j] = ld8<KV::F32>(kv.vptr(pv, (id & 15) * 8)); } }
        f32x16 sacc;
#pragma unroll
        for (int r = 0; r < 16; ++r) sacc[r] = 0.f;
#pragma unroll
        for (int s = 0; s < 8; ++s) sacc = __builtin_amdgcn_mfma_f32_32x32x16_bf16(kc[s], *(const LAS bf16x8*)(ql + s * 32), sacc, 0, 0, 0);
        if (PIPE && kb + 1 < nkb) {
            kp_ += kstep_;
#pragma unroll
            for (int s = 0; s < 8; ++s) kc[s] = *(const bf16x8*)(kp_ + 16 * s);
        }
        if (MASK && (kb == 0 || kb == nkb - 1 || p0 + d * kb * 32 < 0)) {
#pragma unroll
            for (int r = 0; r < 16; ++r) { const int kk = kb * 32 + crow(r, hf); const int j = 128 + qi - kk; const bool ok = (j >= 0) && (j <= 128) && (p0 + d * kk >= 0); sacc[r] = ok ? sacc[r] : -INFINITY; }
        }
        float mx = sacc[0];
#pragma unroll
        for (int r = 1; r < 16; ++r) mx = fmaxf(mx, sacc[r]);
        mx = fmaxf(mx, __shfl_xor(mx, 32));
        const float mn = fmaxf(m, mx * scale_log2), alpha = __builtin_amdgcn_exp2f(m - mn); m = mn;
        float ls = 0.f;
#pragma unroll
        for (int r = 0; r < 16; ++r) { const float p = __builtin_amdgcn_exp2f(__builtin_fmaf(sacc[r], scale_log2, -mn)); ls += p; sacc[r] = p; }
        l = l * alpha + ls;
        if (__builtin_amdgcn_ballot_w64(alpha != 1.f) != 0ull) {
#pragma unroll
            for (int mb = 0; mb < 4; ++mb)
#pragma unroll
                for (int r = 0; r < 16; ++r) o[mb][r] *= alpha;
        }
        bf16x8 pf[2];
#pragma unroll
        for (int st = 0; st < 2; ++st) { u32x4 w; w.x = pk2(sacc[8 * st + 0], sacc[8 * st + 1]); w.y = pk2(sacc[8 * st + 2], sacc[8 * st + 3]); w.z = pk2(sacc[8 * st + 4], sacc[8 * st + 5]); w.w = pk2(sacc[8 * st + 6], sacc[8 * st + 7]);
            pf[st] = __builtin_bit_cast(bf16x8, w); }
#pragma unroll
        for (int j = 0; j < 8; ++j) { const int id = lane + 64 * j; *(LAS bf16x8*)(vl + (id >> 4) * VP + (id & 15) * 16) = vc[j]; }
        if (PIPE && kb + 1 < nkb) {
            vp_ += vstep_;
#pragma unroll
            for (int j = 0; j < 8; ++j) vc[j] = *(const bf16x8*)(vp_ + j * vj_);
        }
        LDS_WAIT();
        {
            const LAS unsigned char* trb = vl + (4 * hf + ((lane & 15) >> 2)) * VP + ((lane >> 4) & 1) * 32 + 8 * (lane & 3);
#pragma unroll
            for (int mb = 0; mb < 4; ++mb)
#pragma unroll
                for (int st = 0; st < 2; ++st) {
                    const s16x4 lo = __builtin_amdgcn_ds_read_tr16_b64_v4i16((LAS s16x4*)(trb + (16 * st) * VP + 64 * mb));
                    const s16x4 hi = __builtin_amdgcn_ds_read_tr16_b64_v4i16((LAS s16x4*)(trb + (16 * st + 8) * VP + 64 * mb));
                    const bf16x8 a = __builtin_shufflevector(lo, hi, 0, 1, 2, 3, 4, 5, 6, 7);
                    o[mb] = __builtin_amdgcn_mfma_f32_32x32x16_bf16(a, pf[st], o[mb], 0, 0, 0); } }
        LDS_WAIT();
    }
    l += __shfl_xor(l, 32);
    const float inv = 1.f / l;
    if (qi < nq) {
        bf16_t* orow = obase + (size_t)qi * opitch;
#pragma unroll
        for (int mb = 0; mb < 4; ++mb)
#pragma unroll
            for (int g4 = 0; g4 < 4; ++g4) { u32x2 w; w.x = pk2(o[mb][4 * g4] * inv, o[mb][4 * g4 + 1] * inv); w.y = pk2(o[mb][4 * g4 + 2] * inv, o[mb][4 * g4 + 3] * inv);
                *(u32x2*)(orow + 32 * mb + 8 * g4 + 4 * hf) = w; }
        if (lsebase && hf == 0) lsebase[(size_t)qi * lsepitch] = m * 0.6931471805599453f + logf(l);
    }
}

template <int W>
__device__ __forceinline__ void pool_strip(const bf16_t* proj, bf16_t* diff, int r0, int c0) {
    u32x4 raw[W + 7];
#pragma unroll
    for (int i = 0; i < W + 7; ++i) { const int t = r0 - (W - 1) + i; raw[i] = (u32x4){0u, 0u, 0u, 0u}; if (t >= 0) raw[i] = *(const u32x4*)(proj + (size_t)t * INW + c0); }
    float s[8];
#pragma unroll
    for (int e = 0; e < 8; ++e) s[e] = 0.f;
#pragma unroll
    for (int i = 0; i < W - 1; ++i) { float f[8]; unpack8(raw[i], f);
#pragma unroll
        for (int e = 0; e < 8; ++e) s[e] += f[e]; }
#pragma unroll
    for (int i = 0; i < 8; ++i) { float f[8], fo[8], dv[8]; unpack8(raw[W - 1 + i], f); unpack8(raw[i], fo);
        const int row = r0 + i; const float inv = 1.f / (float)(row + 1 < W ? row + 1 : W);
#pragma unroll
        for (int e = 0; e < 8; ++e) { s[e] += f[e]; dv[e] = s[e] * inv - f[e]; s[e] -= fo[e]; }
        *(u32x4*)(diff + (size_t)row * 1024 + c0) = pack8(dv); }
}
__device__ __forceinline__ void mem_att_unit_lds(const LAS unsigned char* kl, const LAS unsigned char* vl2, const bf16_t* qbase, const float* qgain, const float* qssq, float scale_log2, bf16_t* obase, int lane) {
    const int qi = lane & 31, hf = lane >> 5;
    const bf16_t* qrow = qbase + (size_t)qi * MEMW;
    bf16x8 qf[8];
#pragma unroll
    for (int s = 0; s < 8; ++s) qf[s] = *(const bf16x8*)(qrow + 16 * s + 8 * hf);
    {   const f32x4 q0 = *(const f32x4*)(qssq + qi * 8), q1 = *(const f32x4*)(qssq + qi * 8 + 4);
        const float r1 = rsqrtf(((q0.x + q0.y) + (q0.z + q0.w) + (q1.x + q1.y) + (q1.z + q1.w)) * (1.f / D) + EPS);
        float ss = 0.f;
#pragma unroll
        for (int s = 0; s < 8; ++s) { float f[8]; unpack8(__builtin_bit_cast(u32x4, qf[s]), f);
#pragma unroll
            for (int e = 0; e < 8; ++e) { const float t = f[e] * r1; ss += t * t; } }
        ss += __shfl_xor(ss, 32);
        const float r = rsqrtf(ss * (1.f / HD) + EPS) * r1;
#pragma unroll
        for (int s = 0; s < 8; ++s) { float f[8]; unpack8(__builtin_bit_cast(u32x4, qf[s]), f);
#pragma unroll
            for (int e = 0; e < 8; ++e) f[e] = f[e] * r * qgain[16 * s + 8 * hf + e];
            qf[s] = __builtin_bit_cast(bf16x8, pack8(f)); } }
    f32x16 o[4];
#pragma unroll
    for (int mb = 0; mb < 4; ++mb)
#pragma unroll
        for (int r = 0; r < 16; ++r) o[mb][r] = 0.f;
    float m = -1e30f, l = 0.f;
    const LAS unsigned char* kp = kl + qi * VP + hf * 16;
    const LAS unsigned char* trb = vl2 + (4 * hf + ((lane & 15) >> 2)) * VP + ((lane >> 4) & 1) * 32 + 8 * (lane & 3);
#pragma unroll 2
    for (int kb = 0; kb < 8; ++kb) {
        f32x16 sacc;
#pragma unroll
        for (int r = 0; r < 16; ++r) sacc[r] = 0.f;
#pragma unroll
        for (int s = 0; s < 8; ++s) sacc = __builtin_amdgcn_mfma_f32_32x32x16_bf16(*(const LAS bf16x8*)(kp + kb * 32 * VP + s * 32), qf[s], sacc, 0, 0, 0);
        float mx = sacc[0];
#pragma unroll
        for (int r = 1; r < 16; ++r) mx = fmaxf(mx, sacc[r]);
        mx = fmaxf(mx, __shfl_xor(mx, 32));
        const float mn = fmaxf(m, mx * scale_log2), alpha = __builtin_amdgcn_exp2f(m - mn); m = mn;
        float ls = 0.f;
#pragma unroll
        for (int r = 0; r < 16; ++r) { const float p = __builtin_amdgcn_exp2f(__builtin_fmaf(sacc[r], scale_log2, -mn)); ls += p; sacc[r] = p; }
        l = l * alpha + ls;
        if (__builtin_amdgcn_ballot_w64(alpha != 1.f) != 0ull) {
#pragma unroll
            for (int mb = 0; mb < 4; ++mb)
#pragma unroll
                for (int r = 0; r < 16; ++r) o[mb][r] *= alpha;
        }
        bf16x8 pf[2];
#pragma unroll
        for (int st = 0; st < 2; ++st) { u32x4 w; w.x = pk2(sacc[8 * st + 0], sacc[8 * st + 1]); w.y = pk2(sacc[8 * st + 2], sacc[8 * st + 3]); w.z = pk2(sacc[8 * st + 4], sacc[8 * st + 5]); w.w = pk2(sacc[8 * st + 6], sacc[8 * st + 7]);
            pf[st] = __builtin_bit_cast(bf16x8, w); }
#pragma unroll
        for (int mb = 0; mb < 4; ++mb)
#pragma unroll
            for (int st = 0; st < 2; ++st) {
                const s16x4 lo = __builtin_amdgcn_ds_read_tr16_b64_v4i16((LAS s16x4*)(trb + (kb * 32 + 16 * st) * VP + 64 * mb));
                const s16x4 hi = __builtin_amdgcn_ds_read_tr16_b64_v4i16((LAS s16x4*)(trb + (kb * 32 + 16 * st + 8) * VP + 64 * mb));
                const bf16x8 a = __builtin_shufflevector(lo, hi, 0, 1, 2, 3, 4, 5, 6, 7);
                o[mb] = __builtin_amdgcn_mfma_f32_32x32x16_bf16(a, pf[st], o[mb], 0, 0, 0); }
    }
    l += __shfl_xor(l, 32);
    const float inv = 1.f / l;
    bf16_t* orow = obase + (size_t)qi * MEMW;
#pragma unroll
    for (int mb = 0; mb < 4; ++mb)
#pragma unroll
        for (int g4 = 0; g4 < 4; ++g4) { u32x2 w; w.x = pk2(o[mb][4 * g4] * inv, o[mb][4 * g4 + 1] * inv); w.y = pk2(o[mb][4 * g4 + 2] * inv, o[mb][4 * g4 + 3] * inv);
            *(u32x2*)(orow + 32 * mb + 8 * g4 + 4 * hf) = w; }
}

typedef __attribute__((address_space(4))) const Args CArgs;
__device__ __forceinline__ CArgs* phase_args() { CArgs* p = (CArgs*)__builtin_amdgcn_kernarg_segment_ptr(); asm volatile("" : "+s"(p)); return p; }
constexpr int NPH = 14;
__global__ void __launch_bounds__(512, 2) mega_fwd(Args args) {
    extern __shared__ __attribute__((aligned(16))) unsigned char lds_raw[];
    LAS unsigned char* lds = (LAS unsigned char*)lds_raw;
    const int tid = threadIdx.x, lane = tid & 63, wave = __builtin_amdgcn_readfirstlane(tid >> 6);
    const int G = gridDim.x, bx = blockIdx.x;
    const int gw = bx * 8 + wave, NGW = G * 8;
    const int gt = bx * 512 + tid, NGT = G * 512;
#define out (pa->out)
#define WSP (pa->ws)
#define x_prompt (pa->in[0])
#define x_sample (pa->in[1])
#define state_pool (pa->in[2])
#define cache_win_k (pa->in[3])
#define cache_win_v (pa->in[4])
#define cache_mem_k (pa->in[5])
#define cache_mem_v (pa->in[6])
#define state_conv (pa->in[7])
#define mem_prompt (pa->in[8])
#define norm_mix (pa->in[9])
#define w_in (pa->in[10])
#define q_norm (pa->in[11])
#define k_norm (pa->in[12])
#define w_pool (pa->in[13])
#define pool_scale (pa->in[14])
#define w_out (pa->in[15])
#define norm_mem (pa->in[16])
#define norm_mem_src (pa->in[17])
#define w_mem_q (pa->in[18])
#define w_mem_k (pa->in[19])
#define w_mem_v (pa->in[20])
#define mem_q_norm (pa->in[21])
#define mem_k_norm (pa->in[22])
#define w_mem_o (pa->in[23])
#define norm_ffn (pa->in[24])
#define w_gate (pa->in[25])
#define w_up (pa->in[26])
#define conv_w (pa->in[27])
#define conv_b (pa->in[28])
#define w_down (pa->in[29])
#define WT_IN ((bf16_t*)(WSP + WS_WIN))
#define WT_OUT ((bf16_t*)(WSP + WS_WOUT))
#define WT_MQ ((bf16_t*)(WSP + WS_WMQ))
#define WT_MKV ((bf16_t*)(WSP + WS_WMKV))
#define WT_MO ((bf16_t*)(WSP + WS_WMO))
#define WT_GU ((bf16_t*)(WSP + WS_WGU))
#define WT_DN ((bf16_t*)(WSP + WS_WDN))
#define WT_POOL ((bf16_t*)(WSP + WS_WPOOL))
#define MK ((bf16_t*)(WSP + WS_MK))
#define MV ((bf16_t*)(WSP + WS_MV))
#define MN ((bf16_t*)(WSP + WS_MN))
#define MEMKV ((float*)(WSP + WS_MEMKV))
#define CMK ((bf16_t*)(WSP + WS_CMK))
#define CMV ((bf16_t*)(WSP + WS_CMV))
#define LSE ((float*)(WSP + WS_LSE))
#define H ((bf16_t*)(WSP + WS_H))
#define XRES ((float*)(WSP + WS_XRES))
#define QM ((bf16_t*)(WSP + WS_QM))
#define OM ((bf16_t*)(WSP + WS_OM))
#define PROJ ((bf16_t*)(WSP + WS_PROJ))
#define QN ((bf16_t*)(WSP + WS_QN))
#define KN ((bf16_t*)(WSP + WS_KN))
#define DIFF ((bf16_t*)(WSP + WS_DIFF))
#define MIXED ((bf16_t*)(WSP + WS_MIXED))
#define OP ((bf16_t*)(WSP + WS_OP))
#define PSSQ1 ((float*)(WSP))
#define PSSQ2 ((float*)(WSP + 512 * 1024))
#define SSQ1 ((float*)(WSP + WS_SSQ1))
#define SSQ2 ((float*)(WSP + WS_SSQ2))
#define FIRSTG ((float*)(WSP + WS_FG))
#define FIRSTUP ((float*)(WSP + WS_FU))
#define LASTG ((float*)(WSP + WS_LG))
#define GB ((bf16_t*)(WSP + WS_G))
#define UPB ((bf16_t*)(WSP + WS_UP))
    volatile LAS unsigned* bst = (volatile LAS unsigned*)(lds + LDS_BYTES - 16);
    if (tid == 0) { bst[0] = 0u; bst[1] = 0u; }
    __syncthreads();
    XcdBarrier gbar = xcd_barrier_post((unsigned*)(args.ws + WS_BAR), bst);
    const int lo = args.ph_lo, hi = args.ph_hi;
#define IN(k) ((((PHMASK) >> (k)) & 1) && lo <= (k) && (k) < hi)
#define SEAM(k) do { if (args.coop == 2) cg::this_grid().sync(); else if (args.coop) xcd_barrier(gbar); } while (0)
    constexpr float SCALE_LOG2 = 0.08838834764831845f * 1.4426950408889634f;

    if (IN(0)) { CArgs* pa = phase_args();
        LAS float* scr = (LAS float*)(lds + wave * 17408);
        constexpr int I_IN = 32 * 64, I_OUT = 32 * 32, I_MQ = 32 * 8, I_MO = 8 * 32, I_G = 32 * 88, I_DN = 88 * 32, I_PL = 4 * 4;
        constexpr int NIT = I_IN + I_OUT + 3 * I_MQ + I_MO + 4 * I_PL;
        for (int it = gw; it < NIT; it += NGW) {
            int r = it;
            if (r < I_IN) { transpose_mat(w_in, D, INW, WT_IN, 0, 0, nullptr, nullptr, r, scr, lane); continue; } r -= I_IN;
            if (r < I_OUT) { transpose_mat(w_out, D, D, WT_OUT, 0, 0, nullptr, nullptr, r, scr, lane); continue; } r -= I_OUT;
            if (r < I_MQ) { transpose_mat(w_mem_q, D, MEMW, WT_MQ, 0, 0, nullptr, norm_mem, r, scr, lane); continue; } r -= I_MQ;
            if (r < I_MQ) { transpose_mat(w_mem_k, D, MEMW, WT_MKV, 0, 0, nullptr, nullptr, r, scr, lane); continue; } r -= I_MQ;
            if (r < I_MQ) { transpose_mat(w_mem_v, D, MEMW, WT_MKV, 0, 512, nullptr, nullptr, r, scr, lane); continue; } r -= I_MQ;
            if (r < I_MO) { transpose_mat(w_mem_o, MEMW, D, WT_MO, 0, 0, nullptr, nullptr, r, scr, lane); continue; } r -= I_MO;
            { const int g = r / I_PL; transpose_mat(w_pool + (size_t)g * 65536, 256, 256, WT_POOL, 0, g * 256, pool_scale, nullptr, r % I_PL, scr, lane); }
        }
        for (int idx = gt; idx < 65536; idx += NGT) SSQ1[idx] = 0.f;
        {
#define P0_SRC(m_) ((m_) < T ? x_prompt + (size_t)(m_) * D : ((m_) < MR ? x_sample + (size_t)((m_) - T) * D : mem_prompt + (size_t)((m_) - MR) * D))
            f32x4 v[8], nv[8];
            int m = gw;
            if (m < MR + NMEM) { const float* xs = P0_SRC(m);
#pragma unroll
                for (int j = 0; j < 8; ++j) v[j] = ((const f32x4*)xs)[lane + 64 * j]; }
            for (; m < MR + NMEM; m += NGW) {
                const int nm = m + NGW;
#pragma unroll
                for (int j = 0; j < 8; ++j) nv[j] = v[j];
                if (nm < MR + NMEM) { const float* xs = P0_SRC(nm);
#pragma unroll
                    for (int j = 0; j < 8; ++j) nv[j] = ((const f32x4*)xs)[lane + 64 * j]; }
                const float* gain = m < MR ? norm_mix : norm_mem_src; bf16_t* o = m < MR ? H + (size_t)m * D : MN + (size_t)(m - MR) * D;
                float ssum = 0.f;
#pragma unroll
                for (int j = 0; j < 8; ++j) ssum += (v[j].x * v[j].x + v[j].y * v[j].y) + (v[j].z * v[j].z + v[j].w * v[j].w);
                const float r = rsqrtf(wave_sum(ssum) * (1.f / D) + EPS);
#pragma unroll
                for (int j = 0; j < 8; ++j) { const f32x4 gn = ((const f32x4*)gain)[lane + 64 * j]; u32x2 w; w.x = pk2(v[j].x * r * gn.x, v[j].y * r * gn.y); w.y = pk2(v[j].z * r * gn.z, v[j].w * r * gn.w);
                    ((u32x2*)o)[lane + 64 * j] = w; }
#pragma unroll
                for (int j = 0; j < 8; ++j) v[j] = nv[j];
            }
#undef P0_SRC
        }
        __syncthreads();
    }
    SEAM(0);
    if (IN(1)) { CArgs* pa = phase_args();
        skinny_gemm(lds, H + (size_t)T * D, D, WT_IN, D, D, INW / 16, 1, bx, G, wave, lane, tid, SkBf16{PROJ + (size_t)T * INW, INW});
        skinny_gemm<4>(lds, MN, D, WT_MKV, D, D, 1024 / 16, 2, bx, G, wave, lane, tid, SkF32{MEMKV, 1024});
        { pg8::Gemm g{H, WT_IN, D, D, D, 0}; pg8::StaticOrder S; S.init(T, INW, G, bx); pg8::EpiBf16 E{PROJ, INW}; pg8::gemm_phase(lds, g, S, E); }
    }
    SEAM(1);
    if (IN(2)) { CArgs* pa = phase_args();
        {
            const int sub = lane & 15, hq = lane >> 4;
#define P2_LOAD(dst, row_) do { const bf16_t* pr_ = PROJ + (size_t)(row_) * INW + 1024 + hq * 128 + sub * 4; _Pragma("unroll") for (int p_ = 0; p_ < 4; ++p_) { dst[2 * p_] = *(const u32x2*)(pr_ + p_ * 512); dst[2 * p_ + 1] = *(const u32x2*)(pr_ + p_ * 512 + 64); } } while (0)
            u32x2 ra[8], rn[8];
            int row = gw;
            if (row < MR) P2_LOAD(ra, row);
            for (; row < MR; row += NGW) {
                const int nrow = row + NGW;
#pragma unroll
                for (int i = 0; i < 8; ++i) rn[i] = ra[i];
                if (nrow < MR) P2_LOAD(rn, nrow);
                const int pos = row < T ? row : T + ((row - T) & 3);
                float cs[4], sn[4];
#pragma unroll
                for (int e = 0; e < 4; ++e) { const double t = (double)pos * INVF[sub * 4 + e] * 0.15915494309189535; const float fr = (float)(t - rint(t));
                    cs[e] = __builtin_amdgcn_cosf(fr); sn[e] = __builtin_amdgcn_sinf(fr); }
                const bf16_t* pr = PROJ + (size_t)row * INW;
#pragma unroll
                for (int p = 0; p < 4; ++p) { const int hh = p * 4 + hq;
                    const u32x2 a1 = ra[2 * p], a2 = ra[2 * p + 1];
                    float x1[4] = {bf2f(a1.x & 0xffffu), bf2f(a1.x >> 16), bf2f(a1.y & 0xffffu), bf2f(a1.y >> 16)};
                    float x2[4] = {bf2f(a2.x & 0xffffu), bf2f(a2.x >> 16), bf2f(a2.y & 0xffffu), bf2f(a2.y >> 16)};
                    float ss = (x1[0] * x1[0] + x1[1] * x1[1]) + (x1[2] * x1[2] + x1[3] * x1[3]) + (x2[0] * x2[0] + x2[1] * x2[1]) + (x2[2] * x2[2] + x2[3] * x2[3]);
                    ss += __shfl_xor(ss, 1); ss += __shfl_xor(ss, 2); ss += __shfl_xor(ss, 4); ss += __shfl_xor(ss, 8);
                    const float rstd = rsqrtf(ss * (1.f / HD) + EPS);
                    const float* gp = hh < 8 ? q_norm : k_norm; const f32x4 g1 = *(const f32x4*)(gp + sub * 4), g2 = *(const f32x4*)(gp + 64 + sub * 4);
                    float o1[4], o2[4];
#pragma unroll
                    for (int e = 0; e < 4; ++e) { const float y1 = x1[e] * rstd * g1[e], y2 = x2[e] * rstd * g2[e]; o1[e] = y1 * cs[e] - y2 * sn[e]; o2[e] = y1 * sn[e] + y2 * cs[e]; }
                    bf16_t* dst = (hh < 8 ? QN : KN) + (size_t)row * 1024 + (hh & 7) * 128 + sub * 4;
                    u32x2 w1, w2; w1.x = pk2(o1[0], o1[1]); w1.y = pk2(o1[2], o1[3]); w2.x = pk2(o2[0], o2[1]); w2.y = pk2(o2[2], o2[3]);
                    *(u32x2*)dst = w1; *(u32x2*)(dst + 64) = w2;
                    if (hh >= 8 && row >= T - 2048) { float* ko = (row < T ? out + O_PWK + (size_t)(row - (T - 2048)) * 1024 : out + O_SWK + (size_t)(row - T) * 1024) + (hh - 8) * 128 + sub * 4;
                        *(f32x4*)ko = (f32x4){o1[0], o1[1], o1[2], o1[3]}; *(f32x4*)(ko + 64) = (f32x4){o2[0], o2[1], o2[2], o2[3]}; } }
                if (row >= T - 2048) { float* vo = row < T ? out + O_PWV + (size_t)(row - (T - 2048)) * 1024 : out + O_SWV + (size_t)(row - T) * 1024;
#pragma unroll
                    for (int j = 0; j < 2; ++j) { float f[8]; unpack8(*(const u32x4*)(pr + 3072 + lane * 8 + 512 * j), f);
                        *(f32x4*)(vo + lane * 8 + 512 * j) = (f32x4){f[0], f[1], f[2], f[3]}; *(f32x4*)(vo + lane * 8 + 512 * j + 4) = (f32x4){f[4], f[5], f[6], f[7]}; } }
#pragma unroll
                for (int i = 0; i < 8; ++i) ra[i] = rn[i];
            }
#undef P2_LOAD
        }
        for (int it = gw; it < 4 * (T / 16); it += NGW) {
            const int g = it & 3, sp = it >> 2, r0 = (2 * sp + (lane >> 5)) * 8, c0 = g * 256 + (lane & 31) * 8;
            if (g == 0) pool_strip<2>(PROJ, DIFF, r0, c0); else if (g == 1) pool_strip<4>(PROJ, DIFF, r0, c0); else if (g == 2) pool_strip<8>(PROJ, DIFF, r0, c0); else pool_strip<16>(PROJ, DIFF, r0, c0);
        }
        for (int it = gw; it < 4 * (NS / 2); it += NGW) {
            const int g = it & 3, rp = it >> 2, row = T + 2 * rp + (lane >> 5), c0 = g * 256 + (lane & 31) * 8, w = 2 << g;
            float acc[8], cur[8];
#pragma unroll
            for (int e = 0; e < 8; ++e) { acc[e] = 0.f; cur[e] = 0.f; }
            const int b = (row - T) >> 2, tq = (row - T) & 3;
            for (int j = 0; j < w; ++j) { const int e15 = 15 + tq - j; float f[8];
                if (e15 >= 15) unpack8(*(const u32x4*)(PROJ + (size_t)(T + b * 4 + e15 - 15) * INW + c0), f);
                else { const float* sp = state_pool + ((size_t)b * 15 + e15) * 1024 + c0; const f32x4 a = *(const f32x4*)sp, bb = *(const f32x4*)(sp + 4);
                    f[0] = a.x; f[1] = a.y; f[2] = a.z; f[3] = a.w; f[4] = bb.x; f[5] = bb.y; f[6] = bb.z; f[7] = bb.w; }
#pragma unroll
                for (int e = 0; e < 8; ++e) { acc[e] += f[e]; if (j == 0) cur[e] = f[e]; } }
            float dv[8];
#pragma unroll
            for (int e = 0; e < 8; ++e) dv[e] = acc[e] / (float)w - cur[e];
            *(u32x4*)(DIFF + (size_t)row * 1024 + c0) = pack8(dv);
        }
        for (int idx = gt; idx < 15 * 1024 + 32 * 15 * 1024; idx += NGT) {
            if (idx < 15 * 1024) { const int e = idx >> 10, c = idx & 1023; out[O_PSP + idx] = bf2f(PROJ[(size_t)(T - 15 + e) * INW + c]); }
            else { const int j = idx - 15 * 1024, b = j / (15 * 1024), e = (j >> 10) % 15, c = j & 1023;
                out[O_SSP + j] = (e + 4 < 15) ? state_pool[((size_t)b * 15 + e + 4) * 1024 + c] : bf2f(PROJ[(size_t)(T + b * 4 + e + 4 - 15) * INW + c]); }
        }
        for (int row = gw; row < NMEM; row += NGW) {
            const float* kp = MEMKV + (size_t)row * 1024 + lane * 8; const f32x4 a = *(const f32x4*)kp, b = *(const f32x4*)(kp + 4);
            float f[8] = {a.x, a.y, a.z, a.w, b.x, b.y, b.z, b.w}; float ss = 0.f;
#pragma unroll
            for (int e = 0; e < 8; ++e) ss += f[e] * f[e];
            ss += __shfl_xor(ss, 1); ss += __shfl_xor(ss, 2); ss += __shfl_xor(ss, 4); ss += __shfl_xor(ss, 8);
            const float rstd = rsqrtf(ss * (1.f / HD) + EPS);
#pragma unroll
            for (int e = 0; e < 8; ++e) f[e] = f[e] * rstd * mem_k_norm[(lane & 15) * 8 + e];
            float* ko = out + O_PMK + (size_t)row * 512 + lane * 8; *(f32x4*)ko = (f32x4){f[0], f[1], f[2], f[3]}; *(f32x4*)(ko + 4) = (f32x4){f[4], f[5], f[6], f[7]};
            *(u32x4*)(MK + (size_t)row * 512 + lane * 8) = pack8(f);
            const float* vp = kp + 512; const f32x4 c = *(const f32x4*)vp, dd = *(const f32x4*)(vp + 4);
            float* vo = out + O_PMV + (size_t)row * 512 + lane * 8; *(f32x4*)vo = c; *(f32x4*)(vo + 4) = dd;
            float fv[8] = {c.x, c.y, c.z, c.w, dd.x, dd.y, dd.z, dd.w}; *(u32x4*)(MV + (size_t)row * 512 + lane * 8) = pack8(fv);
        }
    }
    SEAM(2);
    if (IN(3)) { CArgs* pa = phase_args();
        { pg8::Gemm g{DIFF, WT_POOL, 1024, 256, 256, 512}; pg8::StaticOrder S; S.init(MP, 1024, G, bx); pg8::EpiBf16 E{MIXED, D}; pg8::gemm_phase(lds, g, S, E); }
        __syncthreads();
        {   LAS unsigned char* vl = lds + wave * (32 * VP);
            constexpr int NU_S = 32 * 72;
            for (int u = gw; u < NU_S; u += NGW) {
                const int b = u / 72, rem = u % 72, h = rem / 9, kind = rem % 9;
                const int g = kind == 0 ? 0 : (kind < 5 ? 1 : 2), d = kind == 0 ? 1 : (kind < 5 ? 4 : 16), tq0 = kind == 0 ? 0 : (kind < 5 ? kind - 1 : kind - 5), nq = kind == 0 ? 4 : 1;
                KVSample kv{cache_win_k + ((size_t)b * 2048) * 1024 + h * 128, cache_win_v + ((size_t)b * 2048) * 1024 + h * 128,
                            out + O_SWK + ((size_t)b * 4) * 1024 + h * 128, out + O_SWV + ((size_t)b * 4) * 1024 + h * 128};
                const size_t qr = (size_t)(T + b * 4 + tq0);
                att_unit<KVSample, true, false>(kv, 5, 2048 + tq0 - 128 * d, d, 2048 + tq0 + nq - 1, QN + qr * 1024 + h * 128, 1024, nq, nullptr, nullptr, 0, SCALE_LOG2,
                                                OP + ((size_t)g * MP + qr) * 1024 + h * 128, 1024, LSE + ((size_t)g * MP + qr) * 8 + h, 8, vl, lane);
            }
            __syncthreads(); }
        {   LAS unsigned char* kl = lds; LAS unsigned char* vl2 = lds + 256 * VP;
            constexpr int NGRP = 3 * 8 * 128;
            bf16x8 pk[8], pv[8];
#define DG_DECODE(gid_) const int g_ = (gid_) >> 10, h_ = ((gid_) >> 7) & 7, w_ = (gid_) & 127, d_ = g_ == 0 ? 1 : (g_ == 1 ? 4 : 16), ng_ = 128 / d_, r_ = w_ / ng_, i0_ = (w_ % ng_) * 128
#define DG_LOAD(gid_) do { DG_DECODE(gid_); _Pragma("unroll") for (int j = 0; j < 8; ++j) { const int key = (tid >> 4) + 32 * j, chk = tid & 15; const int pos = r_ + d_ * (i0_ - 128 + key); \
        pk[j] = (bf16x8){0, 0, 0, 0, 0, 0, 0, 0}; pv[j] = pk[j]; if (pos >= 0) { pk[j] = *(const bf16x8*)(KN + (size_t)pos * 1024 + h_ * 128 + chk * 8); pv[j] = *(const bf16x8*)(PROJ + (size_t)pos * INW + 3072 + h_ * 128 + chk * 8); } } } while (0)
            const bool bal = (G == 256);
            const int vj = (bx & 7) * 28 + ((bx >> 3) - 4);
            int gid = bal ? (bx < 32 ? bx * 4 : 128 + vj) : bx;
            const int gstep = bal ? (bx < 32 ? 1 : 224) : G, gend = bal && bx < 32 ? bx * 4 + 4 : NGRP;
            bf16x8 qf[8];
#define DG_QLOAD(gid_) do { const int g2 = (gid_) >> 10, h2 = ((gid_) >> 7) & 7, w2 = (gid_) & 127, d2 = g2 == 0 ? 1 : (g2 == 1 ? 4 : 16), n2 = 128 / d2, r2 = w2 / n2, i2 = (w2 % n2) * 128; \
        const int tq2 = r2 + d2 * (i2 + 32 * (wave & 3) + (lane & 31)); _Pragma("unroll") for (int s2 = 0; s2 < 8; ++s2) qf[s2] = *(const bf16x8*)(QN + (size_t)tq2 * 1024 + h2 * 128 + 16 * s2 + 8 * (lane >> 5)); } while (0)
            if (gid < gend) { DG_LOAD(gid); DG_QLOAD(gid); }
            for (; gid < gend; gid += gstep) {
#pragma unroll
                for (int j = 0; j < 8; ++j) { const int key = (tid >> 4) + 32 * j, chk = tid & 15; *(LAS bf16x8*)(kl + key * VP + chk * 16) = pk[j]; *(LAS bf16x8*)(vl2 + key * VP + chk * 16) = pv[j]; }
                __syncthreads();
                if (gid + gstep < gend) DG_LOAD(gid + gstep);
                DG_DECODE(gid);
                const int ju = wave & 3, half = wave >> 2, qi = lane & 31, hf = lane >> 5;
                const int tq = r_ + d_ * (i0_ + 32 * ju + qi);
                const int pu0 = r_ + d_ * (i0_ + 32 * ju - 128);
                f32x16 o[4];
#pragma unroll
                for (int mb = 0; mb < 4; ++mb)
#pragma unroll
                    for (int r = 0; r < 16; ++r) o[mb][r] = 0.f;
                float m = -1e30f, l = 0.f;
                const LAS unsigned char* kp = kl + (32 * ju + qi) * VP + hf * 16;
                const LAS unsigned char* trb = vl2 + (32 * ju + 4 * hf + ((lane & 15) >> 2)) * VP + ((lane >> 4) & 1) * 32 + 8 * (lane & 3);
                const int kb0 = half ? 3 : 0, kb1 = half ? 5 : 3;
                for (int kb = kb0; kb < kb1; ++kb) {
                    f32x16 sacc;
#pragma unroll
                    for (int r = 0; r < 16; ++r) sacc[r] = 0.f;
#pragma unroll
                    for (int s2 = 0; s2 < 8; ++s2) sacc = __builtin_amdgcn_mfma_f32_32x32x16_bf16(*(const LAS bf16x8*)(kp + kb * 32 * VP + s2 * 32), qf[s2], sacc, 0, 0, 0);
                    if (kb == 0 || kb == 4 || pu0 + d_ * kb * 32 < 0) {
#pragma unroll
                        for (int r = 0; r < 16; ++r) { const int kk = kb * 32 + crow(r, hf); const int jj = 128 + qi - kk; const bool ok = (jj >= 0) && (jj <= 128) && (pu0 + d_ * kk >= 0); sacc[r] = ok ? sacc[r] : -INFINITY; }
                    }
                    float mx = sacc[0];
#pragma unroll
                    for (int r = 1; r < 16; ++r) mx = fmaxf(mx, sacc[r]);
                    mx = fmaxf(mx, __shfl_xor(mx, 32));
                    const float mn = fmaxf(m, mx * SCALE_LOG2), alpha = __builtin_amdgcn_exp2f(m - mn); m = mn;
                    float ls = 0.f;
#pragma unroll
                    for (int r = 0; r < 16; ++r) { const float p = __builtin_amdgcn_exp2f(__builtin_fmaf(sacc[r], SCALE_LOG2, -mn)); ls += p; sacc[r] = p; }
                    l = l * alpha + ls;
                    if (__builtin_amdgcn_ballot_w64(alpha != 1.f) != 0ull) {
#pragma unroll
                        for (int mb = 0; mb < 4; ++mb)
#pragma unroll
                            for (int r = 0; r < 16; ++r) o[mb][r] *= alpha;
                    }
                    bf16x8 pf[2];
#pragma unroll
                    for (int st = 0; st < 2; ++st) { u32x4 w; w.x = pk2(sacc[8 * st + 0], sacc[8 * st + 1]); w.y = pk2(sacc[8 * st + 2], sacc[8 * st + 3]); w.z = pk2(sacc[8 * st + 4], sacc[8 * st + 5]); w.w = pk2(sacc[8 * st + 6], sacc[8 * st + 7]);
                        pf[st] = __builtin_bit_cast(bf16x8, w); }
#pragma unroll
                    for (int mb = 0; mb < 4; ++mb)
#pragma unroll
                        for (int st = 0; st < 2; ++st) {
                            const s16x4 lo = __builtin_amdgcn_ds_read_tr16_b64_v4i16((LAS s16x4*)(trb + (kb * 32 + 16 * st) * VP + 64 * mb));
                            const s16x4 hi = __builtin_amdgcn_ds_read_tr16_b64_v4i16((LAS s16x4*)(trb + (kb * 32 + 16 * st + 8) * VP + 64 * mb));
                            const bf16x8 a = __builtin_shufflevector(lo, hi, 0, 1, 2, 3, 4, 5, 6, 7);
                            o[mb] = __builtin_amdgcn_mfma_f32_32x32x16_bf16(a, pf[st], o[mb], 0, 0, 0); }
                }
                l += __shfl_xor(l, 32);
                if (gid + gstep < gend) DG_QLOAD(gid + gstep);
                __syncthreads();
                LAS float* part = (LAS float*)(kl + ju * 17408);
                if (half) {
#pragma unroll
                    for (int mb = 0; mb < 4; ++mb)
#pragma unroll
                        for (int r = 0; r < 16; ++r) part[(mb * 16 + r) * 64 + lane] = o[mb][r];
                    part[64 * 64 + lane] = m; part[65 * 64 + lane] = l;
                }
                __syncthreads();
                if (!half) {
                    const float mB = part[64 * 64 + lane], lB = part[65 * 64 + lane];
                    const float mt = fmaxf(m, mB), aA = __builtin_amdgcn_exp2f(m - mt), aB = __builtin_amdgcn_exp2f(mB - mt);
                    const float lt = l * aA + lB * aB, inv = 1.f / lt;
                    bf16_t* orow = OP + ((size_t)g_ * MP + tq) * 1024 + h_ * 128;
#pragma unroll
                    for (int mb = 0; mb < 4; ++mb)
#pragma unroll
                        for (int g4 = 0; g4 < 4; ++g4) { float v4[4];
#pragma unroll
                            for (int e = 0; e < 4; ++e) v4[e] = (o[mb][4 * g4 + e] * aA + part[(mb * 16 + 4 * g4 + e) * 64 + lane] * aB) * inv;
                            u32x2 w; w.x = pk2(v4[0], v4[1]); w.y = pk2(v4[2], v4[3]); *(u32x2*)(orow + 32 * mb + 8 * g4 + 4 * hf) = w; }
                    if (hf == 0) LSE[((size_t)g_ * MP + tq) * 8 + h_] = mt * 0.6931471805599453f + logf(lt);
                }
                __syncthreads();
            }
#undef DG_LOAD
#undef DG_QLOAD
#undef DG_DECODE
        }
    }
    SEAM(3);
    if (IN(4)) { CArgs* pa = phase_args();
        for (int idx0 = gt; idx0 < MR * 128; idx0 += 2 * NGT) {
            u32x4 ra[2][3]; float lw[2][3];
#pragma unroll
            for (int q = 0; q < 2; ++q) { const int idx = idx0 + q * NGT; if (idx < MR * 128) { const int row = idx >> 7, ch = idx & 127, h = ch >> 4;
#pragma unroll
                for (int g = 0; g < 3; ++g) { lw[q][g] = LSE[((size_t)g * MP + row) * 8 + h]; ra[q][g] = *(const u32x4*)(OP + ((size_t)g * MP + row) * 1024 + ch * 8); } } }
#pragma unroll
            for (int q = 0; q < 2; ++q) { const int idx = idx0 + q * NGT; if (idx < MR * 128) { const int row = idx >> 7, ch = idx & 127;
                const float mx = fmaxf(lw[q][0], fmaxf(lw[q][1], lw[q][2])); float w0 = __expf(lw[q][0] - mx), w1 = __expf(lw[q][1] - mx), w2 = __expf(lw[q][2] - mx); const float iz = 1.f / (w0 + w1 + w2); w0 *= iz; w1 *= iz; w2 *= iz;
                float a[8], b[8], c[8], o[8]; unpack8(ra[q][0], a); unpack8(ra[q][1], b); unpack8(ra[q][2], c);
#pragma unroll
                for (int e = 0; e < 8; ++e) o[e] = w0 * a[e] + w1 * b[e] + w2 * c[e];
                *(u32x4*)(MIXED + (size_t)row * D + 1024 + ch * 8) = pack8(o); } }
        }
    }
    SEAM(4);
    if (IN(5)) { CArgs* pa = phase_args();
        skinny_gemm<4>(lds, MIXED + (size_t)T * D, D, WT_OUT, D, D, D / 16, 1, bx, G, wave, lane, tid, SkResN{x_sample, XRES + (size_t)T * D, H + (size_t)T * D, SSQ1 + T});
        pg8::Gemm g{MIXED, WT_OUT, D, D, D, 0}; pg8::StaticOrder S; S.init(T, D, G, bx); pg8::EpiResN E{x_prompt, XRES, H, PSSQ1, (LAS float*)(lds + 131072)}; pg8::gemm_phase(lds, g, S, E); }
    SEAM(5);
    if (IN(7)) { CArgs* pa = phase_args();
        {
            constexpr int I_G = 32 * 88, I_DN = 88 * 32;
            const int nidle = G > 128 ? G - 128 : G, myi = G > 128 ? bx - 128 : bx;
            if (myi >= 0) { LAS float* scr = (LAS float*)(lds + wave * 17408);
                for (int it = myi * 8 + wave; it < 2 * I_G + I_DN; it += nidle * 8) { int r = it;
                    if (r < I_G) { transpose_mat(w_gate, D, FF, WT_GU, 1, 0, nullptr, norm_ffn, r, scr, lane); continue; } r -= I_G;
                    if (r < I_G) { transpose_mat(w_up, D, FF, WT_GU, 2, 0, nullptr, norm_ffn, r, scr, lane); continue; } r -= I_G;
                    transpose_mat(w_down, FF, D, WT_DN, 0, 0, nullptr, nullptr, r, scr, lane); }
                for (int idx = myi * 512 + tid; idx < 2 * 524288; idx += nidle * 512) {
                    const int which = idx >= 524288, i8 = which ? idx - 524288 : idx; const float* src = (which ? cache_mem_v : cache_mem_k) + (size_t)i8 * 8;
                    const f32x4 a = *(const f32x4*)src, b = *(const f32x4*)(src + 4); float f[8] = {a.x, a.y, a.z, a.w, b.x, b.y, b.z, b.w};
                    *(u32x4*)((which ? CMV : CMK) + (size_t)i8 * 8) = pack8(f); }
                __syncthreads(); } }
        skinny_gemm<2>(lds, H + (size_t)T * D, D, WT_MQ, D, D, MEMW / 16, 1, bx, G, wave, lane, tid, SkBf16{QM + (size_t)T * MEMW, MEMW});
        pg8::Gemm g{H, WT_MQ, D, D, D, 0}; pg8::StaticOrder S; S.init(T, MEMW, G, bx); pg8::EpiBf16 E{QM, MEMW}; pg8::gemm_phase(lds, g, S, E); }
    SEAM(7);
    if (IN(8)) { CArgs* pa = phase_args();
        LAS unsigned char* kl = lds; LAS unsigned char* vl2 = lds + 256 * VP;
        for (int grp0 = bx; grp0 < 256; grp0 += G) { const int grp = (G == 256) ? (grp0 & 7) * 32 + (grp0 >> 3) : grp0; const int h = grp >> 6;
#pragma unroll
            for (int j = 0; j < 8; ++j) { const int id = tid + 512 * j, key = id >> 4, chk = id & 15;
                *(LAS bf16x8*)(kl + key * VP + chk * 16) = *(const bf16x8*)(MK + (size_t)key * MEMW + h * 128 + chk * 8);
                *(LAS bf16x8*)(vl2 + key * VP + chk * 16) = *(const bf16x8*)(MV + (size_t)key * MEMW + h * 128 + chk * 8); }
            __syncthreads();
            const int ib = (grp * 8 + wave) & 511;
            mem_att_unit_lds(kl, vl2, QM + (size_t)(ib * 32) * MEMW + h * 128, mem_q_norm, PSSQ1 + (size_t)ib * 32 * 8, SCALE_LOG2, OM + (size_t)(ib * 32) * MEMW + h * 128, lane);
            __syncthreads();
        }
        {   LAS unsigned char* vl = lds + wave * (32 * VP);
            for (int s2 = gw; s2 < 128 * 16; s2 += NGW) if ((s2 & 15) == 0) { const int s1 = s2 >> 4, b = s1 >> 2, h = s1 & 3; KVBf16 kv{CMK + (size_t)b * 256 * 512 + h * 128, CMV + (size_t)b * 256 * 512 + h * 128, 512, 512};
                att_unit<KVBf16, false, true>(kv, 8, 0, 1, 255, QM + (size_t)(T + b * 4) * 512 + h * 128, 512, 4, mem_q_norm, SSQ1 + T + b * 4, 1, SCALE_LOG2, OM + (size_t)(T + b * 4) * 512 + h * 128, 512, nullptr, 0, vl, lane); }
            __syncthreads(); }
    }
    SEAM(8);
    if (IN(9)) { CArgs* pa = phase_args();
        skinny_gemm<4>(lds, OM + (size_t)T * MEMW, MEMW, WT_MO, MEMW, MEMW, D / 16, 1, bx, G, wave, lane, tid, SkResN{XRES + (size_t)T * D, XRES + (size_t)T * D, H + (size_t)T * D, SSQ2 + T});
        pg8::Gemm g{OM, WT_MO, MEMW, MEMW, MEMW, 0}; pg8::StaticOrder S; S.init(T, D, G, bx); pg8::EpiResN E{XRES, XRES, H, PSSQ2, (LAS float*)(lds + 131072)}; pg8::gemm_phase(lds, g, S, E); }
    SEAM(9);
    if (IN(11)) { CArgs* pa = phase_args();
        skinny_gemm_nt<3>(lds, H + (size_t)T * D, D, WT_GU, D, D, 2 * FF / 16, 1, bx, G, wave, lane, tid, SkGU{GB + (size_t)T * FF, UPB + (size_t)T * FF, SSQ2 + T});
        pg8::Gemm g{H, WT_GU, D, D, D, 0}; pg8::StaticOrder S; S.init(T, 2 * FF, G, bx); pg8::EpiGUConv E{UPB, PSSQ2, conv_w, conv_b, FIRSTG, FIRSTUP, LASTG, (LAS float*)(lds + 131072 + 4096)}; pg8::gemm_phase(lds, g, S, E); }
    SEAM(11);
    if (IN(12)) { CArgs* pa = phase_args();
        constexpr int NCH = FF / 8;
        for (int idx = gt; idx < 64 * 2 * NCH; idx += NGT) {
            const int ch = idx % NCH, c0 = ch * 8, j = (idx / NCH) & 1, pm = idx / (2 * NCH), row = pm * 256 + j;
            float a[8];
#pragma unroll
            for (int e = 0; e < 8; ++e) { const int f = c0 + e; const float gc = FIRSTG[((size_t)pm * 2 + j) * FF + f], uu = FIRSTUP[((size_t)pm * 2 + j) * FF + f];
                float g1, g2;
                if (j == 0) { g1 = pm ? LASTG[((size_t)(pm - 1) * 2 + 1) * FF + f] : 0.f; g2 = pm ? LASTG[((size_t)(pm - 1) * 2 + 0) * FF + f] : 0.f; }
                else { g1 = FIRSTG[((size_t)pm * 2 + 0) * FF + f]; g2 = pm ? LASTG[((size_t)(pm - 1) * 2 + 1) * FF + f] : 0.f; }
                const float c = conv_b[f] + conv_w[f] * g2 + conv_w[FF + f] * g1 + conv_w[2 * FF + f] * gc; a[e] = c / (1.f + __expf(-c)) * uu; }
            *(u32x4*)(UPB + (size_t)row * FF + c0) = pack8(a);
        }
        for (int idx = gt; idx < 32 * NCH; idx += NGT) {
            const int b = idx / NCH, ch = idx % NCH, c0 = ch * 8;
            float cw0[8], cw1[8], cw2[8], cbv[8], g2[8], g1[8];
            const float* sp = state_conv + ((size_t)b * 2) * FF + c0;
#pragma unroll
            for (int e = 0; e < 8; ++e) { cw0[e] = conv_w[c0 + e]; cw1[e] = conv_w[FF + c0 + e]; cw2[e] = conv_w[2 * FF + c0 + e]; cbv[e] = conv_b[c0 + e]; g2[e] = sp[e]; g1[e] = sp[FF + e]; }
            for (int i = 0; i < 4; ++i) { const int row = T + b * 4 + i; float gc[8], uu[8], a[8];
                unpack8(*(const u32x4*)(GB + (size_t)row * FF + c0), gc); unpack8(*(const u32x4*)(UPB + (size_t)row * FF + c0), uu);
#pragma unroll
                for (int e = 0; e < 8; ++e) { const float c = cbv[e] + cw0[e] * g2[e] + cw1[e] * g1[e] + cw2[e] * gc[e]; a[e] = c / (1.f + __expf(-c)) * uu[e]; g2[e] = g1[e]; g1[e] = gc[e]; }
                *(u32x4*)(UPB + (size_t)row * FF + c0) = pack8(a); }
        }
        for (int idx = gt; idx < 2 * FF + 32 * 2 * FF; idx += NGT) {
            if (idx < 2 * FF) { const int j = idx / FF, f = idx % FF; out[O_PSC + idx] = LASTG[((size_t)63 * 2 + j) * FF + f]; }
            else { const int q = idx - 2 * FF, b = q / (2 * FF), j = (q / FF) & 1, f = q % FF; out[O_SSC + q] = bf2f(GB[(size_t)(T + b * 4 + 2 + j) * FF + f]); }
        }
    }
    SEAM(12);
    if (IN(13)) { CArgs* pa = phase_args();
        skinny_gemm<4>(lds, UPB + (size_t)T * FF, FF, WT_DN, FF, FF, D / 16, 1, bx, G, wave, lane, tid, SkRes{XRES + (size_t)T * D, out + (size_t)T * D});
        pg8::Gemm g{UPB, WT_DN, FF, FF, FF, 0}; pg8::StaticOrder S; S.init(T, D, G, bx); pg8::EpiRes E{XRES, XRES, MP, out, T}; pg8::gemm_phase(lds, g, S, E); }
#undef IN
#undef SEAM
}

#undef out
#undef H
#undef WSP
extern "C" void kernel_launch(void* const* d_in, const int* in_sizes, int n_in, void* d_out, int out_size, void* d_ws, size_t ws_size, hipStream_t stream) {
    static int grid = 0;
    if (grid == 0) {
        if (n_in != 30 || (size_t)out_size != O_END || ws_size < WS_END4) { fprintf(stderr, "kernel_launch: unexpected shapes: n_in %d out %d ws %zu (need %zu)\n", n_in, out_size, ws_size, (size_t)WS_END); grid = -1; return; }
        int dev = 0, cus = 0, per_cu = 0;
        if (hipGetDevice(&dev) != hipSuccess || hipDeviceGetAttribute(&cus, hipDeviceAttributeMultiprocessorCount, dev) != hipSuccess) { grid = -1; return; }
        if (hipFuncSetAttribute((const void*)mega_fwd, hipFuncAttributeMaxDynamicSharedMemorySize, LDS_BYTES) != hipSuccess) { fprintf(stderr, "kernel_launch: hipFuncSetAttribute failed\n"); grid = -1; return; }
        if (hipOccupancyMaxActiveBlocksPerMultiprocessor(&per_cu, (const void*)mega_fwd, 512, LDS_BYTES) != hipSuccess || per_cu < 1) { fprintf(stderr, "kernel_launch: occupancy query gives %d\n", per_cu); per_cu = 1; }
        (void)hipGetLastError();
        grid = cus * 1;
    }
    if (grid < 0) return;
    if (hipMemsetAsync((char*)d_ws + WS_BAR, 0, WS_BAR_BYTES, stream) != hipSuccess) { fprintf(stderr, "kernel_launch: memset of the barrier words failed\n"); return; }
    Args a{};
    for (int i = 0; i < 30; ++i) a.in[i] = (const float*)d_in[i];
    a.out = (float*)d_out; a.ws = (unsigned char*)d_ws;
#if MK_COOP
    a.ph_lo = 0; a.ph_hi = NPH; a.coop = 1;
    void* kargs[] = {&a};
    hipError_t e = hipLaunchCooperativeKernel((const void*)mega_fwd, dim3(grid), dim3(512), kargs, LDS_BYTES, stream);
    if (e != hipSuccess) fprintf(stderr, "kernel_launch: cooperative launch failed: %s (grid %d)\n", hipGetErrorString(e), grid);
#else
    for (int ph = 0; ph < NPH; ++ph) {
        a.ph_lo = ph; a.ph_hi = ph + 1; a.coop = 0;
        hipLaunchKernelGGL(mega_fwd, dim3(grid), dim3(512), LDS_BYTES, stream, a);
    }
#endif
}
```

```cpp
#include <hip/hip_runtime.h>
#include <hip/hip_cooperative_groups.h>
#include <cstdio>
#include <cstdint>
namespace cg = cooperative_groups;

#ifndef MK_COOP
#define MK_COOP 1
#endif
#ifndef PHMASK
#define PHMASK 0x3fff
#endif

#define LAS __attribute__((address_space(3)))
typedef unsigned short bf16_t;
typedef short bf16x8 __attribute__((ext_vector_type(8)));
typedef float f32x4 __attribute__((ext_vector_type(4)));
typedef float f32x16 __attribute__((ext_vector_type(16)));
typedef unsigned u32x4 __attribute__((ext_vector_type(4)));
typedef unsigned u32x2 __attribute__((ext_vector_type(2)));
typedef short s16x4 __attribute__((ext_vector_type(4)));
typedef float f32x2_t __attribute__((ext_vector_type(2)));
typedef __bf16 bf16x2_t __attribute__((ext_vector_type(2)));

constexpr int T = 16384, D = 2048, NS = 128, MR = T + NS, MP = 16640;
constexpr int INW = 4096, PW = 1024, AW = 1024, FF = 5632, MEMW = 512, NMEM = 256, NH = 8, HD = 128;
constexpr float EPS = 1e-6f;
constexpr size_t O_Y = 0, O_YS = (size_t)T * D, O_PSP = O_YS + (size_t)NS * D, O_PWK = O_PSP + 15 * 1024, O_PWV = O_PWK + 2048 * 1024,
                 O_PMK = O_PWV + 2048 * 1024, O_PMV = O_PMK + 256 * 512, O_PSC = O_PMV + 256 * 512, O_SSP = O_PSC + 2 * FF,
                 O_SWK = O_SSP + 32 * 15 * 1024, O_SWV = O_SWK + 32 * 4 * 1024, O_SSC = O_SWV + 32 * 4 * 1024, O_END = O_SSC + 32 * 2 * FF;
constexpr size_t MiB = 1u << 20;
constexpr size_t WS_WIN = 1 * MiB, WS_WOUT = 17 * MiB, WS_WMQ = 25 * MiB, WS_WMKV = 27 * MiB, WS_WMO = 31 * MiB, WS_WGU = 33 * MiB, WS_WDN = 77 * MiB,
                 WS_WPOOL = 99 * MiB, WS_MK = WS_WPOOL + 512 * 1024, WS_MV = WS_MK + 256 * 1024, WS_MN = 100 * MiB, WS_MEMKV = 101 * MiB,
                 WS_CMK = 102 * MiB, WS_CMV = 110 * MiB, WS_LSE = 118 * MiB, WS_H = 120 * MiB, WS_XRES = 185 * MiB, WS_QM = 315 * MiB, WS_OM = 332 * MiB,
                 WS_PROJ = 349 * MiB, WS_QN = 479 * MiB, WS_KN = 512 * MiB, WS_DIFF = 545 * MiB, WS_MIXED = 578 * MiB, WS_OP = 643 * MiB, WS_END = 741 * MiB,
                 WS_G = 349 * MiB, WS_UP = 528 * MiB;
static_assert(WS_UP + (size_t)MP * FF * 2 <= WS_END && WS_G + (size_t)MP * FF * 2 <= WS_UP, "ws map");
constexpr size_t WS_FG = 741 * MiB, WS_FU = 744 * MiB, WS_LG = 747 * MiB, WS_END2 = 750 * MiB;
constexpr size_t WS_BAR = 752 * MiB, WS_BAR_BYTES = 16384, WS_END4 = 753 * MiB;
constexpr size_t WS_SSQ1 = WS_LSE + 1792 * 1024, WS_SSQ2 = WS_SSQ1 + 128 * 1024;
static_assert(3 * (size_t)MP * 8 * 4 <= 1792 * 1024, "lse");
constexpr int LDS_BYTES = 147456;

__device__ const double INVF[64] = {
1.0, 0.8659643233600653, 0.7498942093324559, 0.6493816315762113,
0.5623413251903491, 0.4869675251658631, 0.4216965034285822, 0.3651741272548377,
0.31622776601683794, 0.27384196342643613, 0.23713737056616552, 0.2053525026457146,
0.1778279410038923, 0.1539926526059492, 0.1333521432163324, 0.11547819846894582,
0.1, 0.08659643233600653, 0.07498942093324558, 0.06493816315762113,
0.05623413251903491, 0.04869675251658631, 0.042169650342858224, 0.03651741272548377,
0.03162277660168379, 0.027384196342643614, 0.023713737056616554, 0.02053525026457146,
0.01778279410038923, 0.01539926526059492, 0.01333521432163324, 0.011547819846894581,
0.01, 0.008659643233600654, 0.007498942093324558, 0.006493816315762113,
0.005623413251903491, 0.004869675251658631, 0.004216965034285823, 0.003651741272548377,
0.0031622776601683794, 0.0027384196342643613, 0.0023713737056616554, 0.002053525026457146,
0.0017782794100389228, 0.001539926526059492, 0.001333521432163324, 0.0011547819846894581,
0.001, 0.0008659643233600654, 0.0007498942093324559, 0.0006493816315762113,
0.0005623413251903491, 0.0004869675251658631, 0.00042169650342858224, 0.0003651741272548377,
0.00031622776601683794, 0.0002738419634264361, 0.00023713737056616554, 0.0002053525026457146,
0.00017782794100389227, 0.0001539926526059492, 0.0001333521432163324, 0.00011547819846894582};

__device__ __forceinline__ float bf2f(unsigned b) { return __uint_as_float(b << 16); }
__device__ __forceinline__ unsigned pk2(float lo, float hi) { f32x2_t v = {lo, hi}; bf16x2_t b = __builtin_convertvector(v, bf16x2_t); return __builtin_bit_cast(unsigned, b); }
__device__ __forceinline__ float wave_sum(float v) {
#pragma unroll
    for (int o = 1; o < 64; o <<= 1) v += __shfl_xor(v, o);
    return v;
}
__device__ __forceinline__ void unpack8(u32x4 w, float* f) {
    f[0] = bf2f(w.x & 0xffffu); f[1] = bf2f(w.x >> 16); f[2] = bf2f(w.y & 0xffffu); f[3] = bf2f(w.y >> 16);
    f[4] = bf2f(w.z & 0xffffu); f[5] = bf2f(w.z >> 16); f[6] = bf2f(w.w & 0xffffu); f[7] = bf2f(w.w >> 16);
}
__device__ __forceinline__ u32x4 pack8(const float* f) { u32x4 o; o.x = pk2(f[0], f[1]); o.y = pk2(f[2], f[3]); o.z = pk2(f[4], f[5]); o.w = pk2(f[6], f[7]); return o; }
#define LDS_WAIT() asm volatile("s_waitcnt lgkmcnt(0)" ::: "memory")

namespace pg8 {
constexpr int BM = 256, BK = 64, HALF = 128, HTB = HALF * BK * 2, STAGE_BYTES = 8 * HTB, NXCD = 8, WGM = 8;
__host__ __device__ __forceinline__ int lds_byte(int r, int c) { const int st = (r >> 4) * 2 + (c >> 5), rr = r & 15, cc = c & 31, ob = rr * 64 + cc * 2; return st * 1024 + (ob ^ (((ob >> 9) & 1) << 5)); }
__host__ __device__ __forceinline__ void stage_rc(int b, int& R, int& C) { const int st = b / 1024, sb = b % 1024, swz = sb ^ (((sb >> 9) & 1) << 5); R = (st >> 1) * 16 + swz / 64; C = (st & 1) * 32 + (swz % 64) / 2; }
__host__ __device__ __forceinline__ int perm32(int rho) { const int n = rho >> 4, i = rho & 15; return 8 * (i >> 2) + 4 * n + (i & 3); }
struct Unit { int pm, pn; };
struct Gemm { const bf16_t* A; const bf16_t* Bt; int lda, ldb, K; long a_pn_off; };
struct StaticOrder {
    int nM, nN, nwg, G, c;
    __host__ __device__ void init(int M, int N, int G_, int c_) { nM = M / BM; nN = N / BM; nwg = nM * nN; G = G_; c = c_; }
    __host__ __device__ bool next(int i, Unit& u) const {
        const long L = (long)i * G + c; if (L >= nwg) return false;
        int wgid = (int)L; { const int q = nwg / NXCD, r = nwg % NXCD, xcd = wgid % NXCD, off = wgid / NXCD; wgid = (xcd < r ? xcd * (q + 1) : r * (q + 1) + (xcd - r) * q) + off; }
        const int nig = WGM * nN, gid = wgid / nig, fm = gid * WGM, gsz = (nM - fm) < WGM ? (nM - fm) : WGM;
        u.pm = fm + ((wgid % nig) % gsz); u.pn = (wgid % nig) / gsz; return true;
    }
};
struct EpiBf16 {
    static constexpr bool PERM = true;
    bf16_t* O; int ldc;
    __device__ __forceinline__ void operator()(const f32x4 (&acc)[2][2][4][2], const Unit& u, int wr, int wc, int fr, int fq) const {
        const int row0 = u.pm * BM + wr * 64 + fr, col0 = u.pn * BM + wc * 32 + 8 * fq;
#pragma unroll
        for (int ai = 0; ai < 2; ++ai)
#pragma unroll
            for (int m = 0; m < 4; ++m) { bf16_t* rowp = O + (size_t)(row0 + ai * HALF + m * 16) * ldc + col0;
#pragma unroll
                for (int bj = 0; bj < 2; ++bj) { const f32x4 v0 = acc[ai][bj][m][0], v1 = acc[ai][bj][m][1];
                    u32x4 w; w.x = pk2(v0[0], v0[1]); w.y = pk2(v0[2], v0[3]); w.z = pk2(v1[0], v1[1]); w.w = pk2(v1[2], v1[3]);
                    *(u32x4*)(rowp + bj * HALF) = w; } }
    }
};
struct EpiGU {
    static constexpr bool PERM = true;
    bf16_t* G; bf16_t* UP; const float* ssq;
    __device__ __forceinline__ void operator()(const f32x4 (&acc)[2][2][4][2], const Unit& u, int wr, int wc, int fr, int fq) const {
        const int row0 = u.pm * BM + wr * 64 + fr, col0 = u.pn * HALF + wc * 32 + 8 * fq;
#pragma unroll
        for (int ai = 0; ai < 2; ++ai)
#pragma unroll
            for (int m = 0; m < 4; ++m) { const size_t off = (size_t)(row0 + ai * HALF + m * 16) * FF + col0; const f32x4 q0 = *(const f32x4*)(ssq + (size_t)(row0 + ai * HALF + m * 16) * 8), q1 = *(const f32x4*)(ssq + (size_t)(row0 + ai * HALF + m * 16) * 8 + 4); const float rs = rsqrtf(((q0.x + q0.y) + (q0.z + q0.w) + (q1.x + q1.y) + (q1.z + q1.w)) * (1.f / D) + EPS);
#pragma unroll
                for (int bj = 0; bj < 2; ++bj) { const f32x4 v0 = acc[ai][bj][m][0] * rs, v1 = acc[ai][bj][m][1] * rs;
                    u32x4 w; w.x = pk2(v0[0], v0[1]); w.y = pk2(v0[2], v0[3]); w.z = pk2(v1[0], v1[1]); w.w = pk2(v1[2], v1[3]);
                    *(u32x4*)((bj ? UP : G) + off) = w; } }
    }
};
struct EpiF32 {
    static constexpr bool PERM = false;
    float* O; int ldc;
    __device__ __forceinline__ void operator()(const f32x4 (&acc)[2][2][4][2], const Unit& u, int wr, int wc, int fr, int fq) const {
        const int row0 = u.pm * BM + wr * 64 + fr, col0 = u.pn * BM + wc * 32 + 4 * fq;
#pragma unroll
        for (int ai = 0; ai < 2; ++ai)
#pragma unroll
            for (int m = 0; m < 4; ++m) { float* rowp = O + (size_t)(row0 + ai * HALF + m * 16) * ldc + col0;
#pragma unroll
                for (int bj = 0; bj < 2; ++bj)
#pragma unroll
                    for (int n = 0; n < 2; ++n) *(f32x4*)(rowp + bj * HALF + n * 16) = acc[ai][bj][m][n]; }
    }
};
struct EpiRes {
    static constexpr bool PERM = false;
    const float* base0; const float* base1; int split; float* out; int nrows;
    __device__ __forceinline__ void operator()(const f32x4 (&acc)[2][2][4][2], const Unit& u, int wr, int wc, int fr, int fq) const {
        const int row0 = u.pm * BM + wr * 64 + fr, col0 = u.pn * BM + wc * 32 + 4 * fq;
#pragma unroll
        for (int ai = 0; ai < 2; ++ai)
#pragma unroll
            for (int m = 0; m < 4; ++m) { const int row = row0 + ai * HALF + m * 16;
                if (row < nrows) {
                    const float* bp = (row < split ? base0 + (size_t)row * D : base1 + (size_t)(row - split) * D) + col0; float* op = out + (size_t)row * D + col0;
#pragma unroll
                    for (int bj = 0; bj < 2; ++bj)
#pragma unroll
                        for (int n = 0; n < 2; ++n) { const f32x4 b = *(const f32x4*)(bp + bj * HALF + n * 16); *(f32x4*)(op + bj * HALF + n * 16) = b + acc[ai][bj][m][n]; } } }
    }
};

__device__ __forceinline__ float dpp_ror1(float x) { return __int_as_float(__builtin_amdgcn_update_dpp(0, __float_as_int(x), 0x121, 0xf, 0xf, false)); }
__device__ __forceinline__ float dpp_ror2(float x) { return __int_as_float(__builtin_amdgcn_update_dpp(0, __float_as_int(x), 0x122, 0xf, 0xf, false)); }
struct EpiGUConv {
    static constexpr bool PERM = true;
    bf16_t* ACT; const float* pssq; const float* cw; const float* cb; float* firstg; float* firstup; float* lastg; LAS float* X;
    __device__ __forceinline__ float rsq(int row) const { const f32x4 q0 = *(const f32x4*)(pssq + (size_t)row * 8), q1 = *(const f32x4*)(pssq + (size_t)row * 8 + 4);
        return rsqrtf(((q0.x + q0.y) + (q0.z + q0.w) + (q1.x + q1.y) + (q1.z + q1.w)) * (1.f / D) + EPS); }
    __device__ __forceinline__ void operator()(const f32x4 (&acc)[2][2][4][2], const Unit& u, int wr, int wc, int fr, int fq) const {
        const int ch0 = u.pn * HALF + wc * 32 + 8 * fq, rowb = u.pm * BM + wr * 64 + fr;
        f32x4 w0[2], w1[2], w2[2], bb[2];
#pragma unroll
        for (int n = 0; n < 2; ++n) { w0[n] = *(const f32x4*)(cw + ch0 + 4 * n); w1[n] = *(const f32x4*)(cw + FF + ch0 + 4 * n); w2[n] = *(const f32x4*)(cw + 2 * FF + ch0 + 4 * n); bb[n] = *(const f32x4*)(cb + ch0 + 4 * n); }
#pragma unroll
        for (int ai = 0; ai < 2; ++ai) { const float rs = rsq(rowb + ai * HALF + 48);
            if (fr >= 14) {
#pragma unroll
                for (int n = 0; n < 2; ++n) *(LAS f32x4*)(X + ((((ai * 2 + wr) * 4 + wc) * 2 + (fr - 14)) * 32 + 8 * fq + 4 * n)) = acc[ai][0][3][n] * rs; } }
        asm volatile("s_waitcnt lgkmcnt(0)" ::: "memory"); __builtin_amdgcn_s_barrier(); asm volatile("" ::: "memory");
#pragma unroll
        for (int ai = 0; ai < 2; ++ai) {
            f32x4 gprev[2];
            if (wr == 1 || ai == 1) { const int sai = (wr == 1) ? ai : ai - 1, swr = (wr == 1) ? 0 : 1; const LAS float* xp = X + (((sai * 2 + swr) * 4 + wc) * 2) * 32 + 8 * fq;
#pragma unroll
                for (int n = 0; n < 2; ++n) { const f32x4 h2 = *(const LAS f32x4*)(xp + 4 * n), h1 = *(const LAS f32x4*)(xp + 32 + 4 * n); gprev[n] = (fr == 15) ? h1 : h2; } }
            else { gprev[0] = (f32x4){0.f, 0.f, 0.f, 0.f}; gprev[1] = gprev[0]; }
#pragma unroll
            for (int m = 0; m < 4; ++m) { const int row = rowb + ai * HALF + m * 16; const float rs = rsq(row);
                f32x4 g[2], a[2];
#pragma unroll
                for (int n = 0; n < 2; ++n) { g[n] = acc[ai][0][m][n] * rs; const f32x4 up = acc[ai][1][m][n] * rs;
#pragma unroll
                    for (int e = 0; e < 4; ++e) { const float r1c = dpp_ror1(g[n][e]), r1p = dpp_ror1(gprev[n][e]), r2c = dpp_ror2(g[n][e]), r2p = dpp_ror2(gprev[n][e]);
                        const float p1 = fr >= 1 ? r1c : r1p, p2 = fr >= 2 ? r2c : r2p;
                        const float c = bb[n][e] + w0[n][e] * p2 + w1[n][e] * p1 + w2[n][e] * g[n][e]; a[n][e] = c / (1.f + __expf(-c)) * up[e]; }
                    if (ai == 0 && m == 0 && wr == 0 && fr < 2) { *(f32x4*)(firstg + ((size_t)u.pm * 2 + fr) * FF + ch0 + 4 * n) = g[n]; *(f32x4*)(firstup + ((size_t)u.pm * 2 + fr) * FF + ch0 + 4 * n) = up; }
                    if (ai == 1 && m == 3 && wr == 1 && fr >= 14) *(f32x4*)(lastg + ((size_t)u.pm * 2 + (fr - 14)) * FF + ch0 + 4 * n) = g[n]; }
                if (!(ai == 0 && m == 0 && wr == 0 && fr < 2)) { u32x4 w; w.x = pk2(a[0][0], a[0][1]); w.y = pk2(a[0][2], a[0][3]); w.z = pk2(a[1][0], a[1][1]); w.w = pk2(a[1][2], a[1][3]);
                    *(u32x4*)(ACT + (size_t)row * FF + ch0) = w; }
                gprev[0] = g[0]; gprev[1] = g[1]; }
        }
    }
};

struct EpiResN {
    static constexpr bool PERM = false;
    const float* base; float* out; bf16_t* xb; float* pssq; LAS float* sred;
    __device__ __forceinline__ void operator()(const f32x4 (&acc)[2][2][4][2], const Unit& u, int wr, int wc, int fr, int fq) const {
        const int row0 = u.pm * BM + wr * 64 + fr, col0 = u.pn * BM + wc * 32 + 4 * fq;
#pragma unroll
        for (int ai = 0; ai < 2; ++ai)
#pragma unroll
            for (int m = 0; m < 4; ++m) { const int row = row0 + ai * HALF + m * 16;
                const float* bp = base + (size_t)row * D + col0; float* op = out + (size_t)row * D + col0; bf16_t* xp = xb + (size_t)row * D + col0;
                float ss = 0.f;
#pragma unroll
                for (int bj = 0; bj < 2; ++bj)
#pragma unroll
                    for (int n = 0; n < 2; ++n) { const f32x4 b = *(const f32x4*)(bp + bj * HALF + n * 16); const f32x4 x = b + acc[ai][bj][m][n]; *(f32x4*)(op + bj * HALF + n * 16) = x;
                        u32x2 w; w.x = pk2(x.x, x.y); w.y = pk2(x.z, x.w); *(u32x2*)(xp + bj * HALF + n * 16) = w; ss += (x.x * x.x + x.y * x.y) + (x.z * x.z + x.w * x.w); }
                ss += __shfl_xor(ss, 16); ss += __shfl_xor(ss, 32);
                if (fq == 0) sred[wc * 256 + ai * HALF + wr * 64 + m * 16 + fr] = ss; }
        asm volatile("s_waitcnt lgkmcnt(0)" ::: "memory"); __builtin_amdgcn_s_barrier(); asm volatile("" ::: "memory");
        const int t = threadIdx.x;
        if (t < 256) pssq[(size_t)(u.pm * BM + t) * 8 + u.pn] = (sred[t] + sred[256 + t]) + (sred[512 + t] + sred[768 + t]);
    }
};

template <class Epi, class Sched>
__device__ __forceinline__ void gemm_phase(LAS unsigned char* lds, const Gemm g, const Sched& S, const Epi& E) {
    const int tid = threadIdx.x, wid = __builtin_amdgcn_readfirstlane(tid >> 6), lane = tid & 63, wr = wid >> 2, wc = wid & 3, fr = lane & 15, fq = lane >> 4;
    const int K = g.K, nt = K / BK;
    unsigned voffA[2], voffB[2];
#pragma unroll
    for (int i = 0; i < 2; ++i) { int R, C; stage_rc(tid * 16 + i * 8192, R, C); const int Rb = Epi::PERM ? ((R & ~31) + perm32(R & 31)) : R;
        voffA[i] = (unsigned)(R * g.lda + C) * 2u; voffB[i] = (unsigned)(Rb * g.ldb + C) * 2u; }
    const size_t kstep = (size_t)(BK * 2);
    const size_t hstepA = (size_t)HALF * g.lda * 2, hstepB = (size_t)HALF * g.ldb * 2;
    const size_t tstepA = 2 * hstepA, tstepB = 2 * hstepB;
    const unsigned ldsw = (unsigned)wid * 1024u;
    const int aoff = lds_byte(wr * 64 + fr, fq * 8), boff = lds_byte(wc * 32 + fr, fq * 8);
#define PG8_SA(b, h) (((b) * 2 + (h)) * HTB)
#define PG8_SB(b, h) ((4 + (b) * 2 + (h)) * HTB)
#define PG8_STAGE(bufoff, gbase, voff) do { _Pragma("unroll") for (int _i = 0; _i < 2; ++_i) \
        __builtin_amdgcn_global_load_lds((const unsigned*)((const char*)(gbase) + (voff)[_i]), (LAS unsigned*)(lds + (bufoff) + ldsw + _i * 8192), 16, 0, 0); } while (0)
#define PG8_LDA(dst, b, h) do { _Pragma("unroll") for (int m = 0; m < 4; ++m) _Pragma("unroll") for (int k = 0; k < 2; ++k) dst[m][k] = *(const LAS bf16x8*)(lds + PG8_SA(b, h) + aoff + m * 2048 + k * 1024); } while (0)
#define PG8_LDB(dst, b, h) do { _Pragma("unroll") for (int n = 0; n < 2; ++n) _Pragma("unroll") for (int k = 0; k < 2; ++k) dst[n][k] = *(const LAS bf16x8*)(lds + PG8_SB(b, h) + boff + n * 2048 + k * 1024); } while (0)
#define PG8_MMA(ai, bj, At, Bt) do { __builtin_amdgcn_s_setprio(1); _Pragma("unroll") for (int m = 0; m < 4; ++m) _Pragma("unroll") for (int n = 0; n < 2; ++n) _Pragma("unroll") for (int k = 0; k < 2; ++k) \
        acc[ai][bj][m][n] = __builtin_amdgcn_mfma_f32_16x16x32_bf16(Bt[n][k], At[m][k], acc[ai][bj][m][n], 0, 0, 0); __builtin_amdgcn_s_setprio(0); } while (0)
#define PG8_WAIT_V(n) asm volatile("s_waitcnt vmcnt(" #n ")" ::: "memory")
#define PG8_WAIT_L(n) asm volatile("s_waitcnt lgkmcnt(" #n ")" ::: "memory")
#define PG8_BAR __builtin_amdgcn_s_barrier()
#define PG8_SCHED __builtin_amdgcn_sched_barrier(0)
    Unit cur, nxt; int ui = 0;
    if (!S.next(0, cur)) return;
    f32x4 acc[2][2][4][2];
#pragma unroll
    for (int a = 0; a < 2; ++a)
#pragma unroll
        for (int b = 0; b < 2; ++b)
#pragma unroll
            for (int m = 0; m < 4; ++m)
#pragma unroll
                for (int n = 0; n < 2; ++n) acc[a][b][m][n] = (f32x4){0.f, 0.f, 0.f, 0.f};
    bf16x8 At[4][2], B0[2][2], B1[2][2];
    const char* cA = (const char*)g.A + (size_t)cur.pm * tstepA + (size_t)cur.pn * g.a_pn_off; const char* cB = (const char*)g.Bt + (size_t)cur.pn * tstepB;
    PG8_STAGE(PG8_SB(0, 0), cB, voffB); PG8_STAGE(PG8_SB(0, 1), cB + hstepB, voffB); PG8_STAGE(PG8_SA(0, 0), cA, voffA); PG8_STAGE(PG8_SA(0, 1), cA + hstepA, voffA);
    if (wr == 1) PG8_BAR;
    PG8_WAIT_V(2); PG8_BAR;
    PG8_STAGE(PG8_SB(1, 0), cB + kstep, voffB); PG8_STAGE(PG8_SA(1, 0), cA + kstep, voffA); PG8_STAGE(PG8_SB(1, 1), cB + hstepB + kstep, voffB);
    PG8_WAIT_V(6); PG8_BAR;
    for (;;) {
        const bool has_next = S.next(ui + 1, nxt);
        const char* nA = has_next ? (const char*)g.A + (size_t)nxt.pm * tstepA + (size_t)nxt.pn * g.a_pn_off : cA; const char* nB = has_next ? (const char*)g.Bt + (size_t)nxt.pn * tstepB : cB;
        for (int t = 0; t < nt; t += 2) {
            const bool last = (t == nt - 2);
            const char* a1 = cA + (size_t)(t + 1) * kstep;
            const char* a2 = last ? nA : cA + (size_t)(t + 2) * kstep; const char* b2 = last ? nB : cB + (size_t)(t + 2) * kstep;
            const char* a3 = a2 + kstep; const char* b3 = b2 + kstep;
            PG8_LDB(B0, 0, 0); PG8_LDB(B1, 0, 1); PG8_SCHED; PG8_LDA(At, 0, 0); PG8_STAGE(PG8_SA(1, 1), a1 + hstepA, voffA);
            PG8_WAIT_V(8); PG8_WAIT_L(0); PG8_BAR; PG8_MMA(0, 0, At, B0); PG8_MMA(0, 1, At, B1); PG8_BAR; PG8_SCHED;
            PG8_LDA(At, 0, 1); PG8_STAGE(PG8_SB(0, 0), b2, voffB); PG8_STAGE(PG8_SB(0, 1), b2 + hstepB, voffB); PG8_STAGE(PG8_SA(0, 0), a2, voffA);
            PG8_WAIT_V(8); PG8_WAIT_L(0); PG8_BAR; PG8_MMA(1, 0, At, B0); PG8_MMA(1, 1, At, B1); PG8_BAR; PG8_SCHED;
            PG8_LDB(B0, 1, 0); PG8_LDB(B1, 1, 1); PG8_SCHED; PG8_LDA(At, 1, 0); PG8_STAGE(PG8_SA(0, 1), a2 + hstepA, voffA);
            PG8_WAIT_V(8); PG8_WAIT_L(0); PG8_BAR; PG8_MMA(0, 0, At, B0); PG8_MMA(0, 1, At, B1); PG8_BAR; PG8_SCHED;
            PG8_LDA(At, 1, 1); PG8_STAGE(PG8_SB(1, 0), b3, voffB); PG8_STAGE(PG8_SB(1, 1), b3 + hstepB, voffB); PG8_STAGE(PG8_SA(1, 0), a3, voffA);
            PG8_WAIT_V(8); PG8_WAIT_L(0); PG8_BAR; PG8_MMA(1, 0, At, B0); PG8_MMA(1, 1, At, B1); PG8_BAR; PG8_SCHED;
        }
        if (wr == 0) PG8_BAR;
        E(acc, cur, wr, wc, fr, fq);
        if (!has_next) break;
#pragma unroll
        for (int a = 0; a < 2; ++a)
#pragma unroll
            for (int b = 0; b < 2; ++b)
#pragma unroll
                for (int m = 0; m < 4; ++m)
#pragma unroll
                    for (int n = 0; n < 2; ++n) acc[a][b][m][n] = (f32x4){0.f, 0.f, 0.f, 0.f};
        cur = nxt; cA = nA; cB = nB; ++ui;
        if (wr == 1) PG8_BAR;
    }
    PG8_WAIT_V(0);
    PG8_BAR;
#undef PG8_SA
#undef PG8_SB
#undef PG8_STAGE
#undef PG8_LDA
#undef PG8_LDB
#undef PG8_MMA
#undef PG8_WAIT_V
#undef PG8_WAIT_L
#undef PG8_BAR
#undef PG8_SCHED
}
}


template <int NT, class Epi>
__device__ __forceinline__ void skinny_gemm_nt(LAS unsigned char* lds, const bf16_t* A, int lda, const bf16_t* Wt, int ldb, int K, int nct, int nrh, int bx, int G, int wave, int lane, int tid, const Epi& E) {
    LAS float* red = (LAS float*)lds;
    const int fr = lane & 15, fq = lane >> 4, kw = K / 8, ngrp = (nct + NT - 1) / NT;
    for (int item = bx; item < ngrp * nrh; item += G) {
        const int ctg = item % ngrp, rh = item / ngrp;
        f32x4 acc[NT][8];
#pragma unroll
        for (int t = 0; t < NT; ++t)
#pragma unroll
            for (int rb = 0; rb < 8; ++rb) acc[t][rb] = (f32x4){0.f, 0.f, 0.f, 0.f};
        const bf16_t* bpt[NT];
#pragma unroll
        for (int t = 0; t < NT; ++t) { const int ctt = ctg * NT + t < nct ? ctg * NT + t : nct - 1; bpt[t] = Wt + (size_t)(ctt * 16 + fr) * ldb + wave * kw + fq * 8; }
        const bf16_t* ap = A + (size_t)(rh * 128 + fr) * lda + wave * kw + fq * 8;
        bf16x8 b[NT], a[8];
#pragma unroll
        for (int t = 0; t < NT; ++t) b[t] = *(const bf16x8*)(bpt[t]);
#pragma unroll
        for (int rb = 0; rb < 8; ++rb) a[rb] = *(const bf16x8*)(ap + (size_t)rb * 16 * lda);
        for (int k = 0; k < kw; k += 32) {
            bf16x8 nb[NT], na[8];
#pragma unroll
            for (int t = 0; t < NT; ++t) nb[t] = b[t];
#pragma unroll
            for (int rb = 0; rb < 8; ++rb) na[rb] = a[rb];
            if (k + 32 < kw) {
#pragma unroll
                for (int t = 0; t < NT; ++t) nb[t] = *(const bf16x8*)(bpt[t] + k + 32);
#pragma unroll
                for (int rb = 0; rb < 8; ++rb) na[rb] = *(const bf16x8*)(ap + (size_t)rb * 16 * lda + k + 32);
            }
#pragma unroll
            for (int t = 0; t < NT; ++t)
#pragma unroll
                for (int rb = 0; rb < 8; ++rb) acc[t][rb] = __builtin_amdgcn_mfma_f32_16x16x32_bf16(a[rb], b[t], acc[t][rb], 0, 0, 0);
#pragma unroll
            for (int t = 0; t < NT; ++t) b[t] = nb[t];
#pragma unroll
            for (int rb = 0; rb < 8; ++rb) a[rb] = na[rb];
        }
#pragma unroll
        for (int t = 0; t < NT; ++t) {
#pragma unroll
            for (int rb = 0; rb < 8; ++rb)
#pragma unroll
                for (int j = 0; j < 4; ++j) red[(wave * 128 + rb * 16 + 4 * fq + j) * 16 + fr] = acc[t][rb][j];
            __syncthreads();
            if (ctg * NT + t < nct) { const int e = tid * 4, row = e >> 4, col = e & 15;
                f32x4 v = *(const LAS f32x4*)(red + row * 16 + col);
#pragma unroll
                for (int w = 1; w < 8; ++w) v += *(const LAS f32x4*)(red + (w * 128 + row) * 16 + col);
                E(row, rh, (ctg * NT + t) * 16 + col, v); }
            __syncthreads();
        }
    }
}
template <int RB = 8, class Epi>
__device__ __forceinline__ void skinny_gemm(LAS unsigned char* lds, const bf16_t* A, int lda, const bf16_t* Wt, int ldb, int K, int nct, int nrh, int bx, int G, int wave, int lane, int tid, const Epi& E) {
    LAS float* red = (LAS float*)lds;
    const int fr = lane & 15, fq = lane >> 4, kw = K / 8;
    for (int item = bx; item < nct * nrh * (8 / RB); item += G) {
        const int ct = item % nct, rs = item / nct, row0 = rs * RB * 16, rh = row0 >> 7, rin = row0 & 127;
        f32x4 acc[RB];
#pragma unroll
        for (int rb = 0; rb < RB; ++rb) acc[rb] = (f32x4){0.f, 0.f, 0.f, 0.f};
        const bf16_t* bp = Wt + (size_t)(ct * 16 + fr) * ldb + wave * kw + fq * 8;
        const bf16_t* ap = A + (size_t)(row0 + fr) * lda + wave * kw + fq * 8;
        bf16x8 b0 = *(const bf16x8*)(bp), b1 = *(const bf16x8*)(bp + 32), a0[RB], a1[RB];
#pragma unroll
        for (int rb = 0; rb < RB; ++rb) { a0[rb] = *(const bf16x8*)(ap + (size_t)rb * 16 * lda); a1[rb] = *(const bf16x8*)(ap + (size_t)rb * 16 * lda + 32); }
        for (int k = 0; k < kw; k += 64) {
            bf16x8 nb0 = b0, nb1 = b1, na0[RB], na1[RB];
#pragma unroll
            for (int rb = 0; rb < RB; ++rb) { na0[rb] = a0[rb]; na1[rb] = a1[rb]; }
            if (k + 64 < kw) {
                nb0 = *(const bf16x8*)(bp + k + 64); nb1 = *(const bf16x8*)(bp + k + 96);
#pragma unroll
                for (int rb = 0; rb < RB; ++rb) { na0[rb] = *(const bf16x8*)(ap + (size_t)rb * 16 * lda + k + 64); na1[rb] = *(const bf16x8*)(ap + (size_t)rb * 16 * lda + k + 96); }
            }
#pragma unroll
            for (int rb = 0; rb < RB; ++rb) acc[rb] = __builtin_amdgcn_mfma_f32_16x16x32_bf16(a0[rb], b0, acc[rb], 0, 0, 0);
#pragma unroll
            for (int rb = 0; rb < RB; ++rb) acc[rb] = __builtin_amdgcn_mfma_f32_16x16x32_bf16(a1[rb], b1, acc[rb], 0, 0, 0);
            b0 = nb0; b1 = nb1;
#pragma unroll
            for (int rb = 0; rb < RB; ++rb) { a0[rb] = na0[rb]; a1[rb] = na1[rb]; }
        }
#pragma unroll
        for (int rb = 0; rb < RB; ++rb)
#pragma unroll
            for (int j = 0; j < 4; ++j) red[(wave * (RB * 16) + rb * 16 + 4 * fq + j) * 16 + fr] = acc[rb][j];
        __syncthreads();
        if (tid < RB * 64) { const int e = tid * 4, row = e >> 4, col = e & 15;
            f32x4 v = *(const LAS f32x4*)(red + row * 16 + col);
#pragma unroll
            for (int w = 1; w < 8; ++w) v += *(const LAS f32x4*)(red + (w * (RB * 16) + row) * 16 + col);
            E(rin + row, rh, ct * 16 + col, v); }
        __syncthreads();
    }
}
struct SkBf16 { bf16_t* O; int ldc; __device__ __forceinline__ void operator()(int row, int rh, int col, f32x4 v) const { u32x2 w; w.x = pk2(v.x, v.y); w.y = pk2(v.z, v.w); *(u32x2*)(O + (size_t)(rh * 128 + row) * ldc + col) = w; } };
struct SkF32 { float* O; int ldc; __device__ __forceinline__ void operator()(int row, int rh, int col, f32x4 v) const { *(f32x4*)(O + (size_t)(rh * 128 + row) * ldc + col) = v; } };
struct SkRes { const float* base; float* O; __device__ __forceinline__ void operator()(int row, int rh, int col, f32x4 v) const { const f32x4 b = *(const f32x4*)(base + (size_t)row * D + col); *(f32x4*)(O + (size_t)row * D + col) = b + v; } };
struct SkResN { const float* base; float* O; bf16_t* xb; float* ssq; __device__ __forceinline__ void operator()(int row, int rh, int col, f32x4 v) const { const f32x4 b = *(const f32x4*)(base + (size_t)row * D + col); const f32x4 x = b + v;
    *(f32x4*)(O + (size_t)row * D + col) = x; u32x2 w; w.x = pk2(x.x, x.y); w.y = pk2(x.z, x.w); *(u32x2*)(xb + (size_t)row * D + col) = w; float ss = (x.x * x.x + x.y * x.y) + (x.z * x.z + x.w * x.w); ss += __shfl_xor(ss, 1); ss += __shfl_xor(ss, 2); if ((col & 15) == 0) atomicAdd(ssq + row, ss); } };
struct SkGU { bf16_t* Gp; bf16_t* Up; const float* ssq; __device__ __forceinline__ void operator()(int row, int rh, int col, f32x4 v) const { const int ch = (col >> 8) * 128 + (col & 127); v = v * rsqrtf(ssq[row] * (1.f / D) + EPS); u32x2 w; w.x = pk2(v.x, v.y); w.y = pk2(v.z, v.w);
    *(u32x2*)(Gp + (size_t)((col >> 7) & 1) * ((WS_UP - WS_G) / 2) + (size_t)row * FF + ch) = w; } };

typedef __attribute__((address_space(1))) unsigned gu32;
#define RLX_AGENT __ATOMIC_RELAXED, __HIP_MEMORY_SCOPE_AGENT
#define XB_TMO      128
#define XB_XCNT(j)  (256  + 64 * (j))
#define XB_XSUB(j)  (1280 + 64 * (j))
#define XB_XGEN(j)  (2304 + 64 * (j))
#define XB_TOP      3328
#define XB_TOPGEN   3392
#define XCD_BAR_WORDS 3456
#define XB_SPIN_CAP (1u << 18)

__device__ __forceinline__ unsigned xb_ld(unsigned* p)              { return __hip_atomic_load(p, __ATOMIC_RELAXED, __HIP_MEMORY_SCOPE_AGENT); }
__device__ __forceinline__ unsigned xb_add(unsigned* p, unsigned v) { return __hip_atomic_fetch_add(p, v, __ATOMIC_RELAXED, __HIP_MEMORY_SCOPE_AGENT); }
__device__ __forceinline__ unsigned xb_xcc_id() { return (unsigned)__builtin_amdgcn_s_getreg((3 << 11) | 20) & 0xFu; }
#define XB_SPIN(cond, bar) do { unsigned _sp = 0; while (cond) { __builtin_amdgcn_s_sleep(1); \
    if ((++_sp & 255u) == 0u) { if (xb_ld(&(bar)[XB_TMO])) break; if (_sp > XB_SPIN_CAP) { atomicAdd(&(bar)[XB_TMO], 1u); break; } } } } while (0)

struct XcdBarrier {
    unsigned* bar; unsigned x;
    volatile LAS unsigned* st;
};

__device__ __forceinline__ XcdBarrier xcd_barrier_post(unsigned* bar, volatile LAS unsigned* st) {
    XcdBarrier b; b.bar = bar; b.x = xb_xcc_id(); b.st = st;
    if (threadIdx.x == 0) (void)xb_add(&bar[XB_XCNT(b.x)], 1u);
    return b;
}
__device__ __forceinline__ void xcd_barrier_complete(unsigned* bar, unsigned x, unsigned& nloc, unsigned& nx) {
    const unsigned G = gridDim.x * gridDim.y * gridDim.z;
    unsigned sum, cnt, mine, sp = 0u;
    for (;;) {
        sum = 0u; cnt = 0u; mine = 0u;
#pragma unroll
        for (unsigned j = 0; j < 16; ++j) { const unsigned c = xb_ld(&bar[XB_XCNT(j)]); sum += c; cnt += (c > 0u) ? 1u : 0u; mine = (j == x) ? c : mine; }
        if (sum == G) break;
        __builtin_amdgcn_s_sleep(1);
        if ((++sp & 255u) == 0u) { if (xb_ld(&bar[XB_TMO])) break; if (sp > XB_SPIN_CAP) { atomicAdd(&bar[XB_TMO], 1u); break; } }
    }
    nloc = mine > 0u ? mine : 1u; nx = cnt > 0u ? cnt : 1u;
}

__device__ __forceinline__ void xcd_barrier(const XcdBarrier& b) {
    asm volatile("s_waitcnt vmcnt(0)" ::: "memory");
    __syncthreads();
    if (threadIdx.x == 0) {
        unsigned* bar = b.bar;
        __builtin_amdgcn_s_waitcnt(0);
        unsigned nloc = b.st[0], nx = b.st[1];
        if (nloc == 0u) { xcd_barrier_complete(bar, b.x, nloc, nx); b.st[0] = nloc; b.st[1] = nx; }
        const unsigned old = xb_add(&bar[XB_XSUB(b.x)], 1u);
        const unsigned gen = old / nloc;
        if (old + 1u == (gen + 1u) * nloc) {
            __builtin_amdgcn_fence(__ATOMIC_RELEASE, "agent");
            asm volatile("s_waitcnt vmcnt(0)" ::: "memory");
            const unsigned og = xb_add(&bar[XB_TOP], 1u);
            const unsigned tg = og / nx;
            if (og + 1u == (tg + 1u) * nx) xb_add(&bar[XB_TOPGEN], 1u);
            else XB_SPIN(xb_ld(&bar[XB_TOPGEN]) == tg, bar);
            __builtin_amdgcn_fence(__ATOMIC_ACQUIRE, "agent");
            xb_add(&bar[XB_XGEN(b.x)], 1u);
            asm volatile("s_waitcnt vmcnt(0)" ::: "memory");
        } else {
            XB_SPIN(xb_ld(&bar[XB_XGEN(b.x)]) == gen, bar);
            __builtin_amdgcn_fence(__ATOMIC_ACQUIRE, "agent");
            asm volatile("s_waitcnt vmcnt(0)" ::: "memory");
        }
    }
    __syncthreads();
}

struct Args { const float* in[30]; float* out; unsigned char* ws; int ph_lo, ph_hi, coop, pad; };

__device__ __forceinline__ void transpose_item(const float* W, int N, bf16_t* WT, int ldk, int out_row0, int k0, int n0, const float* nscale, const float* kscale, LAS float* scr, int lane) {
    f32x4 v[16];
#pragma unroll
    for (int i = 0; i < 16; ++i) v[i] = *(const f32x4*)(W + (size_t)(k0 + (lane >> 4) + 4 * i) * N + n0 + 4 * (lane & 15));
#pragma unroll
    for (int i = 0; i < 16; ++i) { const int kk = (lane >> 4) + 4 * i; const float ks = kscale ? kscale[k0 + kk] : 1.f;
        *(LAS f32x4*)(scr + kk * 68 + ((4 * (lane & 15)) ^ (4 * ((kk >> 3) & 7)))) = v[i] * ks; }
    LDS_WAIT();
    const int c = lane & 7;
#pragma unroll
    for (int j = 0; j < 8; ++j) { const int n = (lane >> 3) + 8 * j; const LAS float* sp = scr + (8 * c) * 68 + (n ^ (4 * c)); const float sc = nscale ? nscale[out_row0 + n] : 1.f;
        u32x4 o; o.x = pk2(sp[0 * 68] * sc, sp[1 * 68] * sc); o.y = pk2(sp[2 * 68] * sc, sp[3 * 68] * sc); o.z = pk2(sp[4 * 68] * sc, sp[5 * 68] * sc); o.w = pk2(sp[6 * 68] * sc, sp[7 * 68] * sc);
        *(u32x4*)(WT + (size_t)(out_row0 + n) * ldk + k0 + 8 * c) = o; }
    LDS_WAIT();
}
__device__ __forceinline__ void transpose_mat(const float* W, int K, int N, bf16_t* WT, int mode, int row_off, const float* nscale, const float* kscale, int r, LAS float* scr, int lane) {
    const int nnb = N / 64, kb = r / nnb, nb = r % nnb, n0 = nb * 64, k0 = kb * 64;
    const int orow = mode == 0 ? row_off + n0 : (mode == 1 ? (n0 >> 7) * 256 + (n0 & 127) : (n0 >> 7) * 256 + 128 + (n0 & 127));
    transpose_item(W, N, WT, K, orow, k0, n0, nscale, kscale, scr, lane);
}
__device__ __forceinline__ void rms_row(const float* x, const float* gain, bf16_t* o, int lane) {
    f32x4 v[8]; float s = 0.f;
#pragma unroll
    for (int j = 0; j < 8; ++j) { v[j] = ((const f32x4*)x)[lane + 64 * j]; s += (v[j].x * v[j].x + v[j].y * v[j].y) + (v[j].z * v[j].z + v[j].w * v[j].w); }
    const float r = rsqrtf(wave_sum(s) * (1.f / D) + EPS);
#pragma unroll
    for (int j = 0; j < 8; ++j) { const f32x4 gn = ((const f32x4*)gain)[lane + 64 * j]; u32x2 w; w.x = pk2(v[j].x * r * gn.x, v[j].y * r * gn.y); w.y = pk2(v[j].z * r * gn.z, v[j].w * r * gn.w);
        ((u32x2*)o)[lane + 64 * j] = w; }
}

__device__ __forceinline__ int crow(int r, int hi) { return (r & 3) + 8 * (r >> 2) + 4 * hi; }
template <bool F32> __device__ __forceinline__ bf16x8 ld8(const void* p) {
    if constexpr (F32) { const f32x4 a = ((const f32x4*)p)[0], b = ((const f32x4*)p)[1]; u32x4 o; o.x = pk2(a.x, a.y); o.y = pk2(a.z, a.w); o.z = pk2(b.x, b.y); o.w = pk2(b.z, b.w); return __builtin_bit_cast(bf16x8, o); }
    else return *(const bf16x8*)p;
}
struct KVBf16 { static constexpr bool F32 = false; const bf16_t* K; const bf16_t* V; long kp, vp;
    __device__ __forceinline__ const void* kptr(int pos, int e) const { return K + (size_t)pos * kp + e; }
    __device__ __forceinline__ const void* vptr(int pos, int e) const { return V + (size_t)pos * vp + e; } };
struct KVSample { static constexpr bool F32 = true; const float* ck; const float* cv; const float* nk; const float* nv;
    __device__ __forceinline__ const void* kptr(int pos, int e) const { return (pos < 2048 ? ck + (size_t)pos * 1024 : nk + (size_t)(pos - 2048) * 1024) + e; }
    __device__ __forceinline__ const void* vptr(int pos, int e) const { return (pos < 2048 ? cv + (size_t)pos * 1024 : nv + (size_t)(pos - 2048) * 1024) + e; } };
constexpr int VP = 272;

template <class KV, bool MASK, bool QNORM>
__device__ __forceinline__ void att_unit(const KV& kv, int nkb, int p0, int d, int pmax,
        const bf16_t* qbase, long qpitch, int nq, const float* qgain, const float* qssq, int qnp, float scale_log2,
        bf16_t* obase, long opitch, float* lsebase, long lsepitch, LAS unsigned char* vl, int lane) {
    const int qi = lane & 31, hf = lane >> 5;
    const int qic = qi < nq ? qi : nq - 1;
    const bf16_t* qrow = qbase + (size_t)qic * qpitch;
    bf16x8 qf[8];
#pragma unroll
    for (int s = 0; s < 8; ++s) qf[s] = *(const bf16x8*)(qrow + 16 * s + 8 * hf);
    if constexpr (QNORM) {
        float q1s = 0.f; for (int i = 0; i < qnp; ++i) q1s += qssq[qic * qnp + i];
        const float r1 = rsqrtf(q1s * (1.f / D) + EPS);
        float ss = 0.f;
#pragma unroll
        for (int s = 0; s < 8; ++s) { float f[8]; unpack8(__builtin_bit_cast(u32x4, qf[s]), f);
#pragma unroll
            for (int e = 0; e < 8; ++e) { const float t = f[e] * r1; ss += t * t; } }
        ss += __shfl_xor(ss, 32);
        const float r = rsqrtf(ss * (1.f / HD) + EPS) * r1;
#pragma unroll
        for (int s = 0; s < 8; ++s) { float f[8]; unpack8(__builtin_bit_cast(u32x4, qf[s]), f);
#pragma unroll
            for (int e = 0; e < 8; ++e) f[e] = f[e] * r * qgain[16 * s + 8 * hf + e];
            qf[s] = __builtin_bit_cast(bf16x8, pack8(f)); }
    }
    LAS unsigned char* ql = vl + 8 * 32 * VP + qi * VP + hf * 16;
#pragma unroll
    for (int s = 0; s < 8; ++s) *(LAS bf16x8*)(ql + s * 32) = qf[s];
    f32x16 o[4];
#pragma unroll
    for (int mb = 0; mb < 4; ++mb)
#pragma unroll
        for (int r = 0; r < 16; ++r) o[mb][r] = 0.f;
    float m = -1e30f, l = 0.f;
    constexpr bool PIPE = !KV::F32;
    bf16x8 kc[8], vc[8];
    const bf16_t* kp_ = nullptr; const bf16_t* vp_ = nullptr; long kstep_ = 0, vstep_ = 0, vj_ = 0;
    if constexpr (PIPE) {
        kp_ = (const bf16_t*)kv.kptr(0, 0) + (long)(p0 + d * qi) * kv.kp + 8 * hf; kstep_ = (long)32 * d * kv.kp;
        vp_ = (const bf16_t*)kv.vptr(0, 0) + (long)(p0 + d * (lane >> 4)) * kv.vp + (lane & 15) * 8; vstep_ = (long)32 * d * kv.vp; vj_ = (long)4 * d * kv.vp;
#pragma unroll
        for (int s = 0; s < 8; ++s) kc[s] = *(const bf16x8*)(kp_ + 16 * s);
#pragma unroll
        for (int j = 0; j < 8; ++j) vc[j] = *(const bf16x8*)(vp_ + j * vj_);
    }
    for (int kb = 0; kb < nkb; ++kb) {
        if constexpr (!PIPE) {   int pos = p0 + d * (kb * 32 + qi); pos = pos < 0 ? 0 : (pos > pmax ? pmax : pos);
#pragma unroll
            for (int s = 0; s < 8; ++s) kc[s] = ld8<KV::F32>(kv.kptr(pos, 16 * s + 8 * hf));
#pragma unroll
            for (int j = 0; j < 8; ++j) { const int id = lane + 64 * j; int pv = p0 + d * (kb * 32 + (id >> 4)); pv = pv < 0 ? 0 : (pv > pmax ? pmax : pv); vc[j] = ld8<KV::F32>(kv.vptr(pv, (id & 15) * 8)); } }
        f32x16 sacc;
#pragma unroll
        for (int r = 0; r < 16; ++r) sacc[r] = 0.f;
#pragma unroll
        for (int s = 0; s < 8; ++s) sacc = __builtin_amdgcn_mfma_f32_32x32x16_bf16(kc[s], *(const LAS bf16x8*)(ql + s * 32), sacc, 0, 0, 0);
        if (PIPE && kb + 1 < nkb) {
            kp_ += kstep_;
#pragma unroll
            for (int s = 0; s < 8; ++s) kc[s] = *(const bf16x8*)(kp_ + 16 * s);
        }
        if (MASK && (kb == 0 || kb == nkb - 1 || p0 + d * kb * 32 < 0)) {
#pragma unroll
            for (int r = 0; r < 16; ++r) { const int kk = kb * 32 + crow(r, hf); const int j = 128 + qi - kk; const bool ok = (j >= 0) && (j <= 128) && (p0 + d * kk >= 0); sacc[r] = ok ? sacc[r] : -INFINITY; }
        }
        float mx = sacc[0];
#pragma unroll
        for (int r = 1; r < 16; ++r) mx = fmaxf(mx, sacc[r]);
        mx = fmaxf(mx, __shfl_xor(mx, 32));
        const float mn = fmaxf(m, mx * scale_log2), alpha = __builtin_amdgcn_exp2f(m - mn); m = mn;
        float ls = 0.f;
#pragma unroll
        for (int r = 0; r < 16; ++r) { const float p = __builtin_amdgcn_exp2f(__builtin_fmaf(sacc[r], scale_log2, -mn)); ls += p; sacc[r] = p; }
        l = l * alpha + ls;
        if (__builtin_amdgcn_ballot_w64(alpha != 1.f) != 0ull) {
#pragma unroll
            for (int mb = 0; mb < 4; ++mb)
#pragma unroll
                for (int r = 0; r < 16; ++r) o[mb][r] *= alpha;
        }
        bf16x8 pf[2];
#pragma unroll
        for (int st = 0; st < 2; ++st) { u32x4 w; w.x = pk2(sacc[8 * st + 0], sacc[8 * st + 1]); w.y = pk2(sacc[8 * st + 2], sacc[8 * st + 3]); w.z = pk2(sacc[8 * st + 4], sacc[8 * st + 5]); w.w = pk2(sacc[8 * st + 6], sacc[8 * st + 7]);
            pf[st] = __builtin_bit_cast(bf16x8, w); }
#pragma unroll
        for (int j = 0; j < 8; ++j) { const int id = lane + 64 * j; *(LAS bf16x8*)(vl + (id >> 4) * VP + (id & 15) * 16) = vc[j]; }
        if (PIPE && kb + 1 < nkb) {
            vp_ += vstep_;
#pragma unroll
            for (int j = 0; j < 8; ++j) vc[j] = *(const bf16x8*)(vp_ + j * vj_);
        }
        LDS_WAIT();
        {
            const LAS unsigned char* trb = vl + (4 * hf + ((lane & 15) >> 2)) * VP + ((lane >> 4) & 1) * 32 + 8 * (lane & 3);
#pragma unroll
            for (int mb = 0; mb < 4; ++mb)
#pragma unroll
                for (int st = 0; st < 2; ++st) {
                    const s16x4 lo = __builtin_amdgcn_ds_read_tr16_b64_v4i16((LAS s16x4*)(trb + (16 * st) * VP + 64 * mb));
                    const s16x4 hi = __builtin_amdgcn_ds_read_tr16_b64_v4i16((LAS s16x4*)(trb + (16 * st + 8) * VP + 64 * mb));
                    const bf16x8 a = __builtin_shufflevector(lo, hi, 0, 1, 2, 3, 4, 5, 6, 7);
                    o[mb] = __builtin_amdgcn_mfma_f32_32x32x16_bf16(a, pf[st], o[mb], 0, 0, 0); } }
        LDS_WAIT();
    }
    l += __shfl_xor(l, 32);
    const float inv = 1.f / l;
    if (qi < nq) {
        bf16_t* orow = obase + (size_t)qi * opitch;
#pragma unroll
        for (int mb = 0; mb < 4; ++mb)
#pragma unroll
            for (int g4 = 0; g4 < 4; ++g4) { u32x2 w; w.x = pk2(o[mb][4 * g4] * inv, o[mb][4 * g4 + 1] * inv); w.y = pk2(o[mb][4 * g4 + 2] * inv, o[mb][4 * g4 + 3] * inv);
                *(u32x2*)(orow + 32 * mb + 8 * g4 + 4 * hf) = w; }
        if (lsebase && hf == 0) lsebase[(size_t)qi * lsepitch] = m * 0.6931471805599453f + logf(l);
    }
}

template <int W>
__device__ __forceinline__ void pool_strip(const bf16_t* proj, bf16_t* diff, int r0, int c0) {
    u32x4 raw[W + 7];
#pragma unroll
    for (int i = 0; i < W + 7; ++i) { const int t = r0 - (W - 1) + i; raw[i] = (u32x4){0u, 0u, 0u, 0u}; if (t >= 0) raw[i] = *(const u32x4*)(proj + (size_t)t * INW + c0); }
    float s[8];
#pragma unroll
    for (int e = 0; e < 8; ++e) s[e] = 0.f;
#pragma unroll
    for (int i = 0; i < W - 1; ++i) { float f[8]; unpack8(raw[i], f);
#pragma unroll
        for (int e = 0; e < 8; ++e) s[e] += f[e]; }
#pragma unroll
    for (int i = 0; i < 8; ++i) { float f[8], fo[8], dv[8]; unpack8(raw[W - 1 + i], f); unpack8(raw[i], fo);
        const int row = r0 + i; const float inv = 1.f / (float)(row + 1 < W ? row + 1 : W);
#pragma unroll
        for (int e = 0; e < 8; ++e) { s[e] += f[e]; dv[e] = s[e] * inv - f[e]; s[e] -= fo[e]; }
        *(u32x4*)(diff + (size_t)row * 1024 + c0) = pack8(dv); }
}
__device__ __forceinline__ void mem_att_unit_lds(const LAS unsigned char* kl, const LAS unsigned char* vl2, const bf16_t* qbase, const float* qgain, const float* qssq, int qnp, int nq, float scale_log2, bf16_t* obase, int lane) {
    const int qi = lane & 31, hf = lane >> 5, qic = qi < nq ? qi : nq - 1;
    const bf16_t* qrow = qbase + (size_t)qic * MEMW;
    bf16x8 qf[8];
#pragma unroll
    for (int s = 0; s < 8; ++s) qf[s] = *(const bf16x8*)(qrow + 16 * s + 8 * hf);
    {   float q1s = 0.f; for (int i = 0; i < qnp; ++i) q1s += qssq[qic * qnp + i];
        const float r1 = rsqrtf(q1s * (1.f / D) + EPS);
        float ss = 0.f;
#pragma unroll
        for (int s = 0; s < 8; ++s) { float f[8]; unpack8(__builtin_bit_cast(u32x4, qf[s]), f);
#pragma unroll
            for (int e = 0; e < 8; ++e) { const float t = f[e] * r1; ss += t * t; } }
        ss += __shfl_xor(ss, 32);
        const float r = rsqrtf(ss * (1.f / HD) + EPS) * r1;
#pragma unroll
        for (int s = 0; s < 8; ++s) { float f[8]; unpack8(__builtin_bit_cast(u32x4, qf[s]), f);
#pragma unroll
            for (int e = 0; e < 8; ++e) f[e] = f[e] * r * qgain[16 * s + 8 * hf + e];
            qf[s] = __builtin_bit_cast(bf16x8, pack8(f)); } }
    f32x16 o[4];
#pragma unroll
    for (int mb = 0; mb < 4; ++mb)
#pragma unroll
        for (int r = 0; r < 16; ++r) o[mb][r] = 0.f;
    float m = -1e30f, l = 0.f;
    const LAS unsigned char* kp = kl + qi * VP + hf * 16;
    const LAS unsigned char* trb = vl2 + (4 * hf + ((lane & 15) >> 2)) * VP + ((lane >> 4) & 1) * 32 + 8 * (lane & 3);
#pragma unroll 2
    for (int kb = 0; kb < 8; ++kb) {
        f32x16 sacc;
#pragma unroll
        for (int r = 0; r < 16; ++r) sacc[r] = 0.f;
#pragma unroll
        for (int s = 0; s < 8; ++s) sacc = __builtin_amdgcn_mfma_f32_32x32x16_bf16(*(const LAS bf16x8*)(kp + kb * 32 * VP + s * 32), qf[s], sacc, 0, 0, 0);
        float mx = sacc[0];
#pragma unroll
        for (int r = 1; r < 16; ++r) mx = fmaxf(mx, sacc[r]);
        mx = fmaxf(mx, __shfl_xor(mx, 32));
        const float mn = fmaxf(m, mx * scale_log2), alpha = __builtin_amdgcn_exp2f(m - mn); m = mn;
        float ls = 0.f;
#pragma unroll
        for (int r = 0; r < 16; ++r) { const float p = __builtin_amdgcn_exp2f(__builtin_fmaf(sacc[r], scale_log2, -mn)); ls += p; sacc[r] = p; }
        l = l * alpha + ls;
        if (__builtin_amdgcn_ballot_w64(alpha != 1.f) != 0ull) {
#pragma unroll
            for (int mb = 0; mb < 4; ++mb)
#pragma unroll
                for (int r = 0; r < 16; ++r) o[mb][r] *= alpha;
        }
        bf16x8 pf[2];
#pragma unroll
        for (int st = 0; st < 2; ++st) { u32x4 w; w.x = pk2(sacc[8 * st + 0], sacc[8 * st + 1]); w.y = pk2(sacc[8 * st + 2], sacc[8 * st + 3]); w.z = pk2(sacc[8 * st + 4], sacc[8 * st + 5]); w.w = pk2(sacc[8 * st + 6], sacc[8 * st + 7]);
            pf[st] = __builtin_bit_cast(bf16x8, w); }
#pragma unroll
        for (int mb = 0; mb < 4; ++mb)
#pragma unroll
            for (int st = 0; st < 2; ++st) {
                const s16x4 lo = __builtin_amdgcn_ds_read_tr16_b64_v4i16((LAS s16x4*)(trb + (kb * 32 + 16 * st) * VP + 64 * mb));
                const s16x4 hi = __builtin_amdgcn_ds_read_tr16_b64_v4i16((LAS s16x4*)(trb + (kb * 32 + 16 * st + 8) * VP + 64 * mb));
                const bf16x8 a = __builtin_shufflevector(lo, hi, 0, 1, 2, 3, 4, 5, 6, 7);
                o[mb] = __builtin_amdgcn_mfma_f32_32x32x16_bf16(a, pf[st], o[mb], 0, 0, 0); }
    }
    l += __shfl_xor(l, 32);
    const float inv = 1.f / l;
    if (qi < nq) { bf16_t* orow = obase + (size_t)qi * MEMW;
#pragma unroll
    for (int mb = 0; mb < 4; ++mb)
#pragma unroll
        for (int g4 = 0; g4 < 4; ++g4) { u32x2 w; w.x = pk2(o[mb][4 * g4] * inv, o[mb][4 * g4 + 1] * inv); w.y = pk2(o[mb][4 * g4 + 2] * inv, o[mb][4 * g4 + 3] * inv);
            *(u32x2*)(orow + 32 * mb + 8 * g4 + 4 * hf) = w; } }
}

typedef __attribute__((address_space(4))) const Args CArgs;
__device__ __forceinline__ CArgs* phase_args() { CArgs* p = (CArgs*)__builtin_amdgcn_kernarg_segment_ptr(); asm volatile("" : "+s"(p)); return p; }
constexpr int NPH = 14;
__global__ void __launch_bounds__(512, 2) mega_fwd(Args args) {
    extern __shared__ __attribute__((aligned(16))) unsigned char lds_raw[];
    LAS unsigned char* lds = (LAS unsigned char*)lds_raw;
    const int tid = threadIdx.x, lane = tid & 63, wave = __builtin_amdgcn_readfirstlane(tid >> 6);
    const int G = gridDim.x, bx = blockIdx.x;
    const int gw = bx * 8 + wave, NGW = G * 8;
    const int gt = bx * 512 + tid, NGT = G * 512;
#define out (pa->out)
#define WSP (pa->ws)
#define x_prompt (pa->in[0])
#define x_sample (pa->in[1])
#define state_pool (pa->in[2])
#define cache_win_k (pa->in[3])
#define cache_win_v (pa->in[4])
#define cache_mem_k (pa->in[5])
#define cache_mem_v (pa->in[6])
#define state_conv (pa->in[7])
#define mem_prompt (pa->in[8])
#define norm_mix (pa->in[9])
#define w_in (pa->in[10])
#define q_norm (pa->in[11])
#define k_norm (pa->in[12])
#define w_pool (pa->in[13])
#define pool_scale (pa->in[14])
#define w_out (pa->in[15])
#define norm_mem (pa->in[16])
#define norm_mem_src (pa->in[17])
#define w_mem_q (pa->in[18])
#define w_mem_k (pa->in[19])
#define w_mem_v (pa->in[20])
#define mem_q_norm (pa->in[21])
#define mem_k_norm (pa->in[22])
#define w_mem_o (pa->in[23])
#define norm_ffn (pa->in[24])
#define w_gate (pa->in[25])
#define w_up (pa->in[26])
#define conv_w (pa->in[27])
#define conv_b (pa->in[28])
#define w_down (pa->in[29])
#define WT_IN ((bf16_t*)(WSP + WS_WIN))
#define WT_OUT ((bf16_t*)(WSP + WS_WOUT))
#define WT_MQ ((bf16_t*)(WSP + WS_WMQ))
#define WT_MKV ((bf16_t*)(WSP + WS_WMKV))
#define WT_MO ((bf16_t*)(WSP + WS_WMO))
#define WT_GU ((bf16_t*)(WSP + WS_WGU))
#define WT_DN ((bf16_t*)(WSP + WS_WDN))
#define WT_POOL ((bf16_t*)(WSP + WS_WPOOL))
#define MK ((bf16_t*)(WSP + WS_MK))
#define MV ((bf16_t*)(WSP + WS_MV))
#define MN ((bf16_t*)(WSP + WS_MN))
#define MEMKV ((float*)(WSP + WS_MEMKV))
#define CMK ((bf16_t*)(WSP + WS_CMK))
#define CMV ((bf16_t*)(WSP + WS_CMV))
#define LSE ((float*)(WSP + WS_LSE))
#define H ((bf16_t*)(WSP + WS_H))
#define XRES ((float*)(WSP + WS_XRES))
#define QM ((bf16_t*)(WSP + WS_QM))
#define OM ((bf16_t*)(WSP + WS_OM))
#define PROJ ((bf16_t*)(WSP + WS_PROJ))
#define QN ((bf16_t*)(WSP + WS_QN))
#define KN ((bf16_t*)(WSP + WS_KN))
#define DIFF ((bf16_t*)(WSP + WS_DIFF))
#define MIXED ((bf16_t*)(WSP + WS_MIXED))
#define OP ((bf16_t*)(WSP + WS_OP))
#define PSSQ1 ((float*)(WSP))
#define PSSQ2 ((float*)(WSP + 512 * 1024))
#define SSQ1 ((float*)(WSP + WS_SSQ1))
#define SSQ2 ((float*)(WSP + WS_SSQ2))
#define FIRSTG ((float*)(WSP + WS_FG))
#define FIRSTUP ((float*)(WSP + WS_FU))
#define LASTG ((float*)(WSP + WS_LG))
#define GB ((bf16_t*)(WSP + WS_G))
#define UPB ((bf16_t*)(WSP + WS_UP))
    volatile LAS unsigned* bst = (volatile LAS unsigned*)(lds + LDS_BYTES - 16);
    if (tid == 0) { bst[0] = 0u; bst[1] = 0u; }
    __syncthreads();
    XcdBarrier gbar = xcd_barrier_post((unsigned*)(args.ws + WS_BAR), bst);
    const int lo = args.ph_lo, hi = args.ph_hi;
#define IN(k) ((((PHMASK) >> (k)) & 1) && lo <= (k) && (k) < hi)
#define SEAM(k) do { if (args.coop == 2) cg::this_grid().sync(); else if (args.coop) xcd_barrier(gbar); } while (0)
    constexpr float SCALE_LOG2 = 0.08838834764831845f * 1.4426950408889634f;

    if (IN(0)) { CArgs* pa = phase_args();
        LAS float* scr = (LAS float*)(lds + wave * 17408);
        constexpr int I_IN = 32 * 64, I_OUT = 32 * 32, I_MQ = 32 * 8, I_MO = 8 * 32, I_G = 32 * 88, I_DN = 88 * 32, I_PL = 4 * 4;
        constexpr int NIT = I_IN + I_OUT + 3 * I_MQ + I_MO + 4 * I_PL;
        for (int it = gw; it < NIT; it += NGW) {
            int r = it;
            if (r < I_IN) { transpose_mat(w_in, D, INW, WT_IN, 0, 0, nullptr, nullptr, r, scr, lane); continue; } r -= I_IN;
            if (r < I_OUT) { transpose_mat(w_out, D, D, WT_OUT, 0, 0, nullptr, nullptr, r, scr, lane); continue; } r -= I_OUT;
            if (r < I_MQ) { transpose_mat(w_mem_q, D, MEMW, WT_MQ, 0, 0, nullptr, norm_mem, r, scr, lane); continue; } r -= I_MQ;
            if (r < I_MQ) { transpose_mat(w_mem_k, D, MEMW, WT_MKV, 0, 0, nullptr, nullptr, r, scr, lane); continue; } r -= I_MQ;
            if (r < I_MQ) { transpose_mat(w_mem_v, D, MEMW, WT_MKV, 0, 512, nullptr, nullptr, r, scr, lane); continue; } r -= I_MQ;
            if (r < I_MO) { transpose_mat(w_mem_o, MEMW, D, WT_MO, 0, 0, nullptr, nullptr, r, scr, lane); continue; } r -= I_MO;
            { const int g = r / I_PL; transpose_mat(w_pool + (size_t)g * 65536, 256, 256, WT_POOL, 0, g * 256, pool_scale, nullptr, r % I_PL, scr, lane); }
        }
        for (int idx = gt; idx < 65536; idx += NGT) SSQ1[idx] = 0.f;
        {
#define P0_SRC(m_) ((m_) < T ? x_prompt + (size_t)(m_) * D : ((m_) < MR ? x_sample + (size_t)((m_) - T) * D : mem_prompt + (size_t)((m_) - MR) * D))
            f32x4 v[8], nv[8];
            int m = gw;
            if (m < MR + NMEM) { const float* xs = P0_SRC(m);
#pragma unroll
                for (int j = 0; j < 8; ++j) v[j] = ((const f32x4*)xs)[lane + 64 * j]; }
            for (; m < MR + NMEM; m += NGW) {
                const int nm = m + NGW;
#pragma unroll
                for (int j = 0; j < 8; ++j) nv[j] = v[j];
                if (nm < MR + NMEM) { const float* xs = P0_SRC(nm);
#pragma unroll
                    for (int j = 0; j < 8; ++j) nv[j] = ((const f32x4*)xs)[lane + 64 * j]; }
                const float* gain = m < MR ? norm_mix : norm_mem_src; bf16_t* o = m < MR ? H + (size_t)m * D : MN + (size_t)(m - MR) * D;
                float ssum = 0.f;
#pragma unroll
                for (int j = 0; j < 8; ++j) ssum += (v[j].x * v[j].x + v[j].y * v[j].y) + (v[j].z * v[j].z + v[j].w * v[j].w);
                const float r = rsqrtf(wave_sum(ssum) * (1.f / D) + EPS);
#pragma unroll
                for (int j = 0; j < 8; ++j) { const f32x4 gn = ((const f32x4*)gain)[lane + 64 * j]; u32x2 w; w.x = pk2(v[j].x * r * gn.x, v[j].y * r * gn.y); w.y = pk2(v[j].z * r * gn.z, v[j].w * r * gn.w);
                    ((u32x2*)o)[lane + 64 * j] = w; }
#pragma unroll
                for (int j = 0; j < 8; ++j) v[j] = nv[j];
            }
#undef P0_SRC
        }
        __syncthreads();
    }
    SEAM(0);
    if (IN(1)) { CArgs* pa = phase_args();
        skinny_gemm(lds, H + (size_t)T * D, D, WT_IN, D, D, INW / 16, 1, bx, G, wave, lane, tid, SkBf16{PROJ + (size_t)T * INW, INW});
        skinny_gemm<4>(lds, MN, D, WT_MKV, D, D, 1024 / 16, 2, bx, G, wave, lane, tid, SkF32{MEMKV, 1024});
        { pg8::Gemm g{H, WT_IN, D, D, D, 0}; pg8::StaticOrder S; S.init(T, INW, G, bx); pg8::EpiBf16 E{PROJ, INW}; pg8::gemm_phase(lds, g, S, E); }
    }
    SEAM(1);
    if (IN(2)) { CArgs* pa = phase_args();
        {
            const int sub = lane & 15, hq = lane >> 4;
#define P2_LOAD(dst, row_) do { const bf16_t* pr_ = PROJ + (size_t)(row_) * INW + 1024 + hq * 128 + sub * 4; _Pragma("unroll") for (int p_ = 0; p_ < 4; ++p_) { dst[2 * p_] = *(const u32x2*)(pr_ + p_ * 512); dst[2 * p_ + 1] = *(const u32x2*)(pr_ + p_ * 512 + 64); } } while (0)
            u32x2 ra[8], rn[8];
            int row = gw;
            if (row < MR) P2_LOAD(ra, row);
            for (; row < MR; row += NGW) {
                const int nrow = row + NGW;
#pragma unroll
                for (int i = 0; i < 8; ++i) rn[i] = ra[i];
                if (nrow < MR) P2_LOAD(rn, nrow);
                const int pos = row < T ? row : T + ((row - T) & 3);
                float cs[4], sn[4];
#pragma unroll
                for (int e = 0; e < 4; ++e) { const double t = (double)pos * INVF[sub * 4 + e] * 0.15915494309189535; const float fr = (float)(t - rint(t));
                    cs[e] = __builtin_amdgcn_cosf(fr); sn[e] = __builtin_amdgcn_sinf(fr); }
                const bf16_t* pr = PROJ + (size_t)row * INW;
#pragma unroll
                for (int p = 0; p < 4; ++p) { const int hh = p * 4 + hq;
                    const u32x2 a1 = ra[2 * p], a2 = ra[2 * p + 1];
                    float x1[4] = {bf2f(a1.x & 0xffffu), bf2f(a1.x >> 16), bf2f(a1.y & 0xffffu), bf2f(a1.y >> 16)};
                    float x2[4] = {bf2f(a2.x & 0xffffu), bf2f(a2.x >> 16), bf2f(a2.y & 0xffffu), bf2f(a2.y >> 16)};
                    float ss = (x1[0] * x1[0] + x1[1] * x1[1]) + (x1[2] * x1[2] + x1[3] * x1[3]) + (x2[0] * x2[0] + x2[1] * x2[1]) + (x2[2] * x2[2] + x2[3] * x2[3]);
                    ss += __shfl_xor(ss, 1); ss += __shfl_xor(ss, 2); ss += __shfl_xor(ss, 4); ss += __shfl_xor(ss, 8);
                    const float rstd = rsqrtf(ss * (1.f / HD) + EPS);
                    const float* gp = hh < 8 ? q_norm : k_norm; const f32x4 g1 = *(const f32x4*)(gp + sub * 4), g2 = *(const f32x4*)(gp + 64 + sub * 4);
                    float o1[4], o2[4];
#pragma unroll
                    for (int e = 0; e < 4; ++e) { const float y1 = x1[e] * rstd * g1[e], y2 = x2[e] * rstd * g2[e]; o1[e] = y1 * cs[e] - y2 * sn[e]; o2[e] = y1 * sn[e] + y2 * cs[e]; }
                    bf16_t* dst = (hh < 8 ? QN : KN) + (size_t)row * 1024 + (hh & 7) * 128 + sub * 4;
                    u32x2 w1, w2; w1.x = pk2(o1[0], o1[1]); w1.y = pk2(o1[2], o1[3]); w2.x = pk2(o2[0], o2[1]); w2.y = pk2(o2[2], o2[3]);
                    *(u32x2*)dst = w1; *(u32x2*)(dst + 64) = w2;
                    if (hh >= 8 && row >= T - 2048) { float* ko = (row < T ? out + O_PWK + (size_t)(row - (T - 2048)) * 1024 : out + O_SWK + (size_t)(row - T) * 1024) + (hh - 8) * 128 + sub * 4;
                        *(f32x4*)ko = (f32x4){o1[0], o1[1], o1[2], o1[3]}; *(f32x4*)(ko + 64) = (f32x4){o2[0], o2[1], o2[2], o2[3]}; } }
                if (row >= T - 2048) { float* vo = row < T ? out + O_PWV + (size_t)(row - (T - 2048)) * 1024 : out + O_SWV + (size_t)(row - T) * 1024;
#pragma unroll
                    for (int j = 0; j < 2; ++j) { float f[8]; unpack8(*(const u32x4*)(pr + 3072 + lane * 8 + 512 * j), f);
                        *(f32x4*)(vo + lane * 8 + 512 * j) = (f32x4){f[0], f[1], f[2], f[3]}; *(f32x4*)(vo + lane * 8 + 512 * j + 4) = (f32x4){f[4], f[5], f[6], f[7]}; } }
#pragma unroll
                for (int i = 0; i < 8; ++i) ra[i] = rn[i];
            }
#undef P2_LOAD
        }
        for (int it = gw; it < 4 * (T / 16); it += NGW) {
            const int g = it & 3, sp = it >> 2, r0 = (2 * sp + (lane >> 5)) * 8, c0 = g * 256 + (lane & 31) * 8;
            if (g == 0) pool_strip<2>(PROJ, DIFF, r0, c0); else if (g == 1) pool_strip<4>(PROJ, DIFF, r0, c0); else if (g == 2) pool_strip<8>(PROJ, DIFF, r0, c0); else pool_strip<16>(PROJ, DIFF, r0, c0);
        }
        for (int it = gw; it < 4 * (NS / 2); it += NGW) {
            const int g = it & 3, rp = it >> 2, row = T + 2 * rp + (lane >> 5), c0 = g * 256 + (lane & 31) * 8, w = 2 << g;
            float acc[8], cur[8];
#pragma unroll
            for (int e = 0; e < 8; ++e) { acc[e] = 0.f; cur[e] = 0.f; }
            const int b = (row - T) >> 2, tq = (row - T) & 3;
            for (int j = 0; j < w; ++j) { const int e15 = 15 + tq - j; float f[8];
                if (e15 >= 15) unpack8(*(const u32x4*)(PROJ + (size_t)(T + b * 4 + e15 - 15) * INW + c0), f);
                else { const float* sp = state_pool + ((size_t)b * 15 + e15) * 1024 + c0; const f32x4 a = *(const f32x4*)sp, bb = *(const f32x4*)(sp + 4);
                    f[0] = a.x; f[1] = a.y; f[2] = a.z; f[3] = a.w; f[4] = bb.x; f[5] = bb.y; f[6] = bb.z; f[7] = bb.w; }
#pragma unroll
                for (int e = 0; e < 8; ++e) { acc[e] += f[e]; if (j == 0) cur[e] = f[e]; } }
            float dv[8];
#pragma unroll
            for (int e = 0; e < 8; ++e) dv[e] = acc[e] / (float)w - cur[e];
            *(u32x4*)(DIFF + (size_t)row * 1024 + c0) = pack8(dv);
        }
        for (int idx = gt; idx < 15 * 1024 + 32 * 15 * 1024; idx += NGT) {
            if (idx < 15 * 1024) { const int e = idx >> 10, c = idx & 1023; out[O_PSP + idx] = bf2f(PROJ[(size_t)(T - 15 + e) * INW + c]); }
            else { const int j = idx - 15 * 1024, b = j / (15 * 1024), e = (j >> 10) % 15, c = j & 1023;
                out[O_SSP + j] = (e + 4 < 15) ? state_pool[((size_t)b * 15 + e + 4) * 1024 + c] : bf2f(PROJ[(size_t)(T + b * 4 + e + 4 - 15) * INW + c]); }
        }
        for (int row = gw; row < NMEM; row += NGW) {
            const float* kp = MEMKV + (size_t)row * 1024 + lane * 8; const f32x4 a = *(const f32x4*)kp, b = *(const f32x4*)(kp + 4);
            float f[8] = {a.x, a.y, a.z, a.w, b.x, b.y, b.z, b.w}; float ss = 0.f;
#pragma unroll
            for (int e = 0; e < 8; ++e) ss += f[e] * f[e];
            ss += __shfl_xor(ss, 1); ss += __shfl_xor(ss, 2); ss += __shfl_xor(ss, 4); ss += __shfl_xor(ss, 8);
            const float rstd = rsqrtf(ss * (1.f / HD) + EPS);
#pragma unroll
            for (int e = 0; e < 8; ++e) f[e] = f[e] * rstd * mem_k_norm[(lane & 15) * 8 + e];
            float* ko = out + O_PMK + (size_t)row * 512 + lane * 8; *(f32x4*)ko = (f32x4){f[0], f[1], f[2], f[3]}; *(f32x4*)(ko + 4) = (f32x4){f[4], f[5], f[6], f[7]};
            *(u32x4*)(MK + (size_t)row * 512 + lane * 8) = pack8(f);
            const float* vp = kp + 512; const f32x4 c = *(const f32x4*)vp, dd = *(const f32x4*)(vp + 4);
            float* vo = out + O_PMV + (size_t)row * 512 + lane * 8; *(f32x4*)vo = c; *(f32x4*)(vo + 4) = dd;
            float fv[8] = {c.x, c.y, c.z, c.w, dd.x, dd.y, dd.z, dd.w}; *(u32x4*)(MV + (size_t)row * 512 + lane * 8) = pack8(fv);
        }
    }
    SEAM(2);
    if (IN(3)) { CArgs* pa = phase_args();
        { pg8::Gemm g{DIFF, WT_POOL, 1024, 256, 256, 512}; pg8::StaticOrder S; S.init(MP, 1024, G, bx); pg8::EpiBf16 E{MIXED, D}; pg8::gemm_phase(lds, g, S, E); }
        __syncthreads();
        {   LAS unsigned char* vl = lds + wave * (32 * VP);
            constexpr int NU_S = 32 * 72;
            for (int u = gw; u < NU_S; u += NGW) {
                const int b = u / 72, rem = u % 72, h = rem / 9, kind = rem % 9;
                const int g = kind == 0 ? 0 : (kind < 5 ? 1 : 2), d = kind == 0 ? 1 : (kind < 5 ? 4 : 16), tq0 = kind == 0 ? 0 : (kind < 5 ? kind - 1 : kind - 5), nq = kind == 0 ? 4 : 1;
                KVSample kv{cache_win_k + ((size_t)b * 2048) * 1024 + h * 128, cache_win_v + ((size_t)b * 2048) * 1024 + h * 128,
                            out + O_SWK + ((size_t)b * 4) * 1024 + h * 128, out + O_SWV + ((size_t)b * 4) * 1024 + h * 128};
                const size_t qr = (size_t)(T + b * 4 + tq0);
                att_unit<KVSample, true, false>(kv, 5, 2048 + tq0 - 128 * d, d, 2048 + tq0 + nq - 1, QN + qr * 1024 + h * 128, 1024, nq, nullptr, nullptr, 0, SCALE_LOG2,
                                                OP + ((size_t)g * MP + qr) * 1024 + h * 128, 1024, LSE + ((size_t)g * MP + qr) * 8 + h, 8, vl, lane);
            }
            __syncthreads(); }
        {   LAS unsigned char* kl = lds; LAS unsigned char* vl2 = lds + 256 * VP;
            constexpr int NGRP = 3 * 8 * 128;
            bf16x8 pk[8], pv[8];
#define DG_DECODE(gid_) const int g_ = (gid_) >> 10, h_ = ((gid_) >> 7) & 7, w_ = (gid_) & 127, d_ = g_ == 0 ? 1 : (g_ == 1 ? 4 : 16), ng_ = 128 / d_, r_ = w_ / ng_, i0_ = (w_ % ng_) * 128
#define DG_LOAD(gid_) do { DG_DECODE(gid_); _Pragma("unroll") for (int j = 0; j < 8; ++j) { const int key = (tid >> 4) + 32 * j, chk = tid & 15; const int pos = r_ + d_ * (i0_ - 128 + key); \
        pk[j] = (bf16x8){0, 0, 0, 0, 0, 0, 0, 0}; pv[j] = pk[j]; if (pos >= 0) { pk[j] = *(const bf16x8*)(KN + (size_t)pos * 1024 + h_ * 128 + chk * 8); pv[j] = *(const bf16x8*)(PROJ + (size_t)pos * INW + 3072 + h_ * 128 + chk * 8); } } } while (0)
            const bool bal = (G == 256);
            int gid = bal ? (bx < 32 ? bx * 4 : 128 + (bx - 32)) : bx;
            const int gstep = bal ? (bx < 32 ? 1 : 224) : G, gend = bal && bx < 32 ? bx * 4 + 4 : NGRP;
            bf16x8 qf[8];
#define DG_QLOAD(gid_) do { const int g2 = (gid_) >> 10, h2 = ((gid_) >> 7) & 7, w2 = (gid_) & 127, d2 = g2 == 0 ? 1 : (g2 == 1 ? 4 : 16), n2 = 128 / d2, r2 = w2 / n2, i2 = (w2 % n2) * 128; \
        const int tq2 = r2 + d2 * (i2 + 32 * (wave & 3) + (lane & 31)); _Pragma("unroll") for (int s2 = 0; s2 < 8; ++s2) qf[s2] = *(const bf16x8*)(QN + (size_t)tq2 * 1024 + h2 * 128 + 16 * s2 + 8 * (lane >> 5)); } while (0)
            if (gid < gend) { DG_LOAD(gid); DG_QLOAD(gid); }
            for (; gid < gend; gid += gstep) {
#pragma unroll
                for (int j = 0; j < 8; ++j) { const int key = (tid >> 4) + 32 * j, chk = tid & 15; *(LAS bf16x8*)(kl + key * VP + chk * 16) = pk[j]; *(LAS bf16x8*)(vl2 + key * VP + chk * 16) = pv[j]; }
                __syncthreads();
                if (gid + gstep < gend) DG_LOAD(gid + gstep);
                DG_DECODE(gid);
                const int ju = wave & 3, half = wave >> 2, qi = lane & 31, hf = lane >> 5;
                const int tq = r_ + d_ * (i0_ + 32 * ju + qi);
                const int pu0 = r_ + d_ * (i0_ + 32 * ju - 128);
                f32x16 o[4];
#pragma unroll
                for (int mb = 0; mb < 4; ++mb)
#pragma unroll
                    for (int r = 0; r < 16; ++r) o[mb][r] = 0.f;
                float m = -1e30f, l = 0.f;
                const LAS unsigned char* kp = kl + (32 * ju + qi) * VP + hf * 16;
                const LAS unsigned char* trb = vl2 + (32 * ju + 4 * hf + ((lane & 15) >> 2)) * VP + ((lane >> 4) & 1) * 32 + 8 * (lane & 3);
                const int kb0 = half ? 3 : 0, kb1 = half ? 5 : 3;
                for (int kb = kb0; kb < kb1; ++kb) {
                    f32x16 sacc;
#pragma unroll
                    for (int r = 0; r < 16; ++r) sacc[r] = 0.f;
#pragma unroll
                    for (int s2 = 0; s2 < 8; ++s2) sacc = __builtin_amdgcn_mfma_f32_32x32x16_bf16(*(const LAS bf16x8*)(kp + kb * 32 * VP + s2 * 32), qf[s2], sacc, 0, 0, 0);
                    if (kb == 0 || kb == 4 || pu0 + d_ * kb * 32 < 0) {
#pragma unroll
                        for (int r = 0; r < 16; ++r) { const int kk = kb * 32 + crow(r, hf); const int jj = 128 + qi - kk; const bool ok = (jj >= 0) && (jj <= 128) && (pu0 + d_ * kk >= 0); sacc[r] = ok ? sacc[r] : -INFINITY; }
                    }
                    float mx = sacc[0];
#pragma unroll
                    for (int r = 1; r < 16; ++r) mx = fmaxf(mx, sacc[r]);
                    mx = fmaxf(mx, __shfl_xor(mx, 32));
                    const float mn = fmaxf(m, mx * SCALE_LOG2), alpha = __builtin_amdgcn_exp2f(m - mn); m = mn;
                    float ls = 0.f;
#pragma unroll
                    for (int r = 0; r < 16; ++r) { const float p = __builtin_amdgcn_exp2f(__builtin_fmaf(sacc[r], SCALE_LOG2, -mn)); ls += p; sacc[r] = p; }
                    l = l * alpha + ls;
                    if (__builtin_amdgcn_ballot_w64(alpha != 1.f) != 0ull) {
#pragma unroll
                        for (int mb = 0; mb < 4; ++mb)
#pragma unroll
                            for (int r = 0; r < 16; ++r) o[mb][r] *= alpha;
                    }
                    bf16x8 pf[2];
#pragma unroll
                    for (int st = 0; st < 2; ++st) { u32x4 w; w.x = pk2(sacc[8 * st + 0], sacc[8 * st + 1]); w.y = pk2(sacc[8 * st + 2], sacc[8 * st + 3]); w.z = pk2(sacc[8 * st + 4], sacc[8 * st + 5]); w.w = pk2(sacc[8 * st + 6], sacc[8 * st + 7]);
                        pf[st] = __builtin_bit_cast(bf16x8, w); }
#pragma unroll
                    for (int mb = 0; mb < 4; ++mb)
#pragma unroll
                        for (int st = 0; st < 2; ++st) {
                            const s16x4 lo = __builtin_amdgcn_ds_read_tr16_b64_v4i16((LAS s16x4*)(trb + (kb * 32 + 16 * st) * VP + 64 * mb));
                            const s16x4 hi = __builtin_amdgcn_ds_read_tr16_b64_v4i16((LAS s16x4*)(trb + (kb * 32 + 16 * st + 8) * VP + 64 * mb));
                            const bf16x8 a = __builtin_shufflevector(lo, hi, 0, 1, 2, 3, 4, 5, 6, 7);
                            o[mb] = __builtin_amdgcn_mfma_f32_32x32x16_bf16(a, pf[st], o[mb], 0, 0, 0); }
                }
                l += __shfl_xor(l, 32);
                if (gid + gstep < gend) DG_QLOAD(gid + gstep);
                __syncthreads();
                LAS float* part = (LAS float*)(kl + ju * 17408);
                if (half) {
#pragma unroll
                    for (int mb = 0; mb < 4; ++mb)
#pragma unroll
                        for (int r = 0; r < 16; ++r) part[(mb * 16 + r) * 64 + lane] = o[mb][r];
                    part[64 * 64 + lane] = m; part[65 * 64 + lane] = l;
                }
                __syncthreads();
                if (!half) {
                    const float mB = part[64 * 64 + lane], lB = part[65 * 64 + lane];
                    const float mt = fmaxf(m, mB), aA = __builtin_amdgcn_exp2f(m - mt), aB = __builtin_amdgcn_exp2f(mB - mt);
                    const float lt = l * aA + lB * aB, inv = 1.f / lt;
                    bf16_t* orow = OP + ((size_t)g_ * MP + tq) * 1024 + h_ * 128;
#pragma unroll
                    for (int mb = 0; mb < 4; ++mb)
#pragma unroll
                        for (int g4 = 0; g4 < 4; ++g4) { float v4[4];
#pragma unroll
                            for (int e = 0; e < 4; ++e) v4[e] = (o[mb][4 * g4 + e] * aA + part[(mb * 16 + 4 * g4 + e) * 64 + lane] * aB) * inv;
                            u32x2 w; w.x = pk2(v4[0], v4[1]); w.y = pk2(v4[2], v4[3]); *(u32x2*)(orow + 32 * mb + 8 * g4 + 4 * hf) = w; }
                    if (hf == 0) LSE[((size_t)g_ * MP + tq) * 8 + h_] = mt * 0.6931471805599453f + logf(lt);
                }
                __syncthreads();
            }
#undef DG_LOAD
#undef DG_QLOAD
#undef DG_DECODE
        }
    }
    SEAM(3);
    if (IN(4)) { CArgs* pa = phase_args();
        for (int idx0 = gt; idx0 < MR * 128; idx0 += 2 * NGT) {
            u32x4 ra[2][3]; float lw[2][3];
#pragma unroll
            for (int q = 0; q < 2; ++q) { const int idx = idx0 + q * NGT; if (idx < MR * 128) { const int row = idx >> 7, ch = idx & 127, h = ch >> 4;
#pragma unroll
                for (int g = 0; g < 3; ++g) { lw[q][g] = LSE[((size_t)g * MP + row) * 8 + h]; ra[q][g] = *(const u32x4*)(OP + ((size_t)g * MP + row) * 1024 + ch * 8); } } }
#pragma unroll
            for (int q = 0; q < 2; ++q) { const int idx = idx0 + q * NGT; if (idx < MR * 128) { const int row = idx >> 7, ch = idx & 127;
                const float mx = fmaxf(lw[q][0], fmaxf(lw[q][1], lw[q][2])); float w0 = __expf(lw[q][0] - mx), w1 = __expf(lw[q][1] - mx), w2 = __expf(lw[q][2] - mx); const float iz = 1.f / (w0 + w1 + w2); w0 *= iz; w1 *= iz; w2 *= iz;
                float a[8], b[8], c[8], o[8]; unpack8(ra[q][0], a); unpack8(ra[q][1], b); unpack8(ra[q][2], c);
#pragma unroll
                for (int e = 0; e < 8; ++e) o[e] = w0 * a[e] + w1 * b[e] + w2 * c[e];
                *(u32x4*)(MIXED + (size_t)row * D + 1024 + ch * 8) = pack8(o); } }
        }
    }
    SEAM(4);
    if (IN(5)) { CArgs* pa = phase_args();
        skinny_gemm<4>(lds, MIXED + (size_t)T * D, D, WT_OUT, D, D, D / 16, 1, bx, G, wave, lane, tid, SkResN{x_sample, XRES + (size_t)T * D, H + (size_t)T * D, SSQ1 + T});
        pg8::Gemm g{MIXED, WT_OUT, D, D, D, 0}; pg8::StaticOrder S; S.init(T, D, G, bx); pg8::EpiResN E{x_prompt, XRES, H, PSSQ1, (LAS float*)(lds + 131072)}; pg8::gemm_phase(lds, g, S, E); }
    SEAM(5);
    if (IN(7)) { CArgs* pa = phase_args();
        {
            constexpr int I_G = 32 * 88, I_DN = 88 * 32;
            const int nidle = G > 128 ? G - 128 : G, myi = G > 128 ? bx - 128 : bx;
            if (myi >= 0) { LAS float* scr = (LAS float*)(lds + wave * 17408);
                for (int it = myi * 8 + wave; it < 2 * I_G + I_DN; it += nidle * 8) { int r = it;
                    if (r < I_G) { transpose_mat(w_gate, D, FF, WT_GU, 1, 0, nullptr, norm_ffn, r, scr, lane); continue; } r -= I_G;
                    if (r < I_G) { transpose_mat(w_up, D, FF, WT_GU, 2, 0, nullptr, norm_ffn, r, scr, lane); continue; } r -= I_G;
                    transpose_mat(w_down, FF, D, WT_DN, 0, 0, nullptr, nullptr, r, scr, lane); }
                for (int idx = myi * 512 + tid; idx < 2 * 524288; idx += nidle * 512) {
                    const int which = idx >= 524288, i8 = which ? idx - 524288 : idx; const float* src = (which ? cache_mem_v : cache_mem_k) + (size_t)i8 * 8;
                    const f32x4 a = *(const f32x4*)src, b = *(const f32x4*)(src + 4); float f[8] = {a.x, a.y, a.z, a.w, b.x, b.y, b.z, b.w};
                    *(u32x4*)((which ? CMV : CMK) + (size_t)i8 * 8) = pack8(f); }
                __syncthreads(); } }
        skinny_gemm<2>(lds, H + (size_t)T * D, D, WT_MQ, D, D, MEMW / 16, 1, bx, G, wave, lane, tid, SkBf16{QM + (size_t)T * MEMW, MEMW});
        pg8::Gemm g{H, WT_MQ, D, D, D, 0}; pg8::StaticOrder S; S.init(T, MEMW, G, bx); pg8::EpiBf16 E{QM, MEMW}; pg8::gemm_phase(lds, g, S, E); }
    SEAM(7);
    if (IN(8)) { CArgs* pa = phase_args();
        LAS unsigned char* kl = lds; LAS unsigned char* vl2 = lds + 256 * VP;
        for (int grp = bx; grp < 256; grp += G) { const int h = grp >> 6;
#pragma unroll
            for (int j = 0; j < 8; ++j) { const int id = tid + 512 * j, key = id >> 4, chk = id & 15;
                *(LAS bf16x8*)(kl + key * VP + chk * 16) = *(const bf16x8*)(MK + (size_t)key * MEMW + h * 128 + chk * 8);
                *(LAS bf16x8*)(vl2 + key * VP + chk * 16) = *(const bf16x8*)(MV + (size_t)key * MEMW + h * 128 + chk * 8); }
            __syncthreads();
            const int ib = (grp * 8 + wave) & 511;
            mem_att_unit_lds(kl, vl2, QM + (size_t)(ib * 32) * MEMW + h * 128, mem_q_norm, PSSQ1 + (size_t)ib * 32 * 8, 8, 32, SCALE_LOG2, OM + (size_t)(ib * 32) * MEMW + h * 128, lane);
            __syncthreads();
        }
        for (int s1 = bx; s1 < 128; s1 += G) { const int b = s1 >> 2, h = s1 & 3;
            const bf16_t* ck = CMK + (size_t)b * 256 * 512 + h * 128; const bf16_t* cv = CMV + (size_t)b * 256 * 512 + h * 128;
#pragma unroll
            for (int j = 0; j < 8; ++j) { const int id = tid + 512 * j, key = id >> 4, chk = id & 15;
                *(LAS bf16x8*)(kl + key * VP + chk * 16) = *(const bf16x8*)(ck + (size_t)key * MEMW + chk * 8);
                *(LAS bf16x8*)(vl2 + key * VP + chk * 16) = *(const bf16x8*)(cv + (size_t)key * MEMW + chk * 8); }
            __syncthreads();
            if (wave == 0) mem_att_unit_lds(kl, vl2, QM + (size_t)(T + b * 4) * MEMW + h * 128, mem_q_norm, SSQ1 + T + b * 4, 1, 4, SCALE_LOG2, OM + (size_t)(T + b * 4) * MEMW + h * 128, lane);
            __syncthreads();
        }
    }
    SEAM(8);
    if (IN(9)) { CArgs* pa = phase_args();
        skinny_gemm<4>(lds, OM + (size_t)T * MEMW, MEMW, WT_MO, MEMW, MEMW, D / 16, 1, bx, G, wave, lane, tid, SkResN{XRES + (size_t)T * D, XRES + (size_t)T * D, H + (size_t)T * D, SSQ2 + T});
        pg8::Gemm g{OM, WT_MO, MEMW, MEMW, MEMW, 0}; pg8::StaticOrder S; S.init(T, D, G, bx); pg8::EpiResN E{XRES, XRES, H, PSSQ2, (LAS float*)(lds + 131072)}; pg8::gemm_phase(lds, g, S, E); }
    SEAM(9);
    if (IN(11)) { CArgs* pa = phase_args();
        skinny_gemm_nt<3>(lds, H + (size_t)T * D, D, WT_GU, D, D, 2 * FF / 16, 1, bx, G, wave, lane, tid, SkGU{GB + (size_t)T * FF, UPB + (size_t)T * FF, SSQ2 + T});
        pg8::Gemm g{H, WT_GU, D, D, D, 0}; pg8::StaticOrder S; S.init(T, 2 * FF, G, bx); pg8::EpiGUConv E{UPB, PSSQ2, conv_w, conv_b, FIRSTG, FIRSTUP, LASTG, (LAS float*)(lds + 131072 + 4096)}; pg8::gemm_phase(lds, g, S, E); }
    SEAM(11);
    if (IN(12)) { CArgs* pa = phase_args();
        constexpr int NCH = FF / 8;
        for (int idx = gt; idx < 64 * 2 * NCH; idx += NGT) {
            const int ch = idx % NCH, c0 = ch * 8, j = (idx / NCH) & 1, pm = idx / (2 * NCH), row = pm * 256 + j;
            float a[8];
#pragma unroll
            for (int e = 0; e < 8; ++e) { const int f = c0 + e; const float gc = FIRSTG[((size_t)pm * 2 + j) * FF + f], uu = FIRSTUP[((size_t)pm * 2 + j) * FF + f];
                float g1, g2;
                if (j == 0) { g1 = pm ? LASTG[((size_t)(pm - 1) * 2 + 1) * FF + f] : 0.f; g2 = pm ? LASTG[((size_t)(pm - 1) * 2 + 0) * FF + f] : 0.f; }
                else { g1 = FIRSTG[((size_t)pm * 2 + 0) * FF + f]; g2 = pm ? LASTG[((size_t)(pm - 1) * 2 + 1) * FF + f] : 0.f; }
                const float c = conv_b[f] + conv_w[f] * g2 + conv_w[FF + f] * g1 + conv_w[2 * FF + f] * gc; a[e] = c / (1.f + __expf(-c)) * uu; }
            *(u32x4*)(UPB + (size_t)row * FF + c0) = pack8(a);
        }
        for (int idx = gt; idx < 32 * NCH; idx += NGT) {
            const int b = idx / NCH, ch = idx % NCH, c0 = ch * 8;
            float cw0[8], cw1[8], cw2[8], cbv[8], g2[8], g1[8];
            const float* sp = state_conv + ((size_t)b * 2) * FF + c0;
#pragma unroll
            for (int e = 0; e < 8; ++e) { cw0[e] = conv_w[c0 + e]; cw1[e] = conv_w[FF + c0 + e]; cw2[e] = conv_w[2 * FF + c0 + e]; cbv[e] = conv_b[c0 + e]; g2[e] = sp[e]; g1[e] = sp[FF + e]; }
            for (int i = 0; i < 4; ++i) { const int row = T + b * 4 + i; float gc[8], uu[8], a[8];
                unpack8(*(const u32x4*)(GB + (size_t)row * FF + c0), gc); unpack8(*(const u32x4*)(UPB + (size_t)row * FF + c0), uu);
#pragma unroll
                for (int e = 0; e < 8; ++e) { const float c = cbv[e] + cw0[e] * g2[e] + cw1[e] * g1[e] + cw2[e] * gc[e]; a[e] = c / (1.f + __expf(-c)) * uu[e]; g2[e] = g1[e]; g1[e] = gc[e]; }
                *(u32x4*)(UPB + (size_t)row * FF + c0) = pack8(a); }
        }
        for (int idx = gt; idx < 2 * FF + 32 * 2 * FF; idx += NGT) {
            if (idx < 2 * FF) { const int j = idx / FF, f = idx % FF; out[O_PSC + idx] = LASTG[((size_t)63 * 2 + j) * FF + f]; }
            else { const int q = idx - 2 * FF, b = q / (2 * FF), j = (q / FF) & 1, f = q % FF; out[O_SSC + q] = bf2f(GB[(size_t)(T + b * 4 + 2 + j) * FF + f]); }
        }
    }
    SEAM(12);
    if (IN(13)) { CArgs* pa = phase_args();
        skinny_gemm<4>(lds, UPB + (size_t)T * FF, FF, WT_DN, FF, FF, D / 16, 1, bx, G, wave, lane, tid, SkRes{XRES + (size_t)T * D, out + (size_t)T * D});
        pg8::Gemm g{UPB, WT_DN, FF, FF, FF, 0}; pg8::StaticOrder S; S.init(T, D, G, bx); pg8::EpiRes E{XRES, XRES, MP, out, T}; pg8::gemm_phase(lds, g, S, E); }
#undef IN
#undef SEAM
}

#undef out
#undef H
#undef WSP
extern "C" void kernel_launch(void* const* d_in, const int* in_sizes, int n_in, void* d_out, int out_size, void* d_ws, size_t ws_size, hipStream_t stream) {
    static int grid = 0;
    if (grid == 0) {
        if (n_in != 30 || (size_t)out_size != O_END || ws_size < WS_END4) { fprintf(stderr, "kernel_launch: unexpected shapes: n_in %d out %d ws %zu (need %zu)\n", n_in, out_size, ws_size, (size_t)WS_END); grid = -1; return; }
        int dev = 0, cus = 0, per_cu = 0;
        if (hipGetDevice(&dev) != hipSuccess || hipDeviceGetAttribute(&cus, hipDeviceAttributeMultiprocessorCount, dev) != hipSuccess) { grid = -1; return; }
        if (hipFuncSetAttribute((const void*)mega_fwd, hipFuncAttributeMaxDynamicSharedMemorySize, LDS_BYTES) != hipSuccess) { fprintf(stderr, "kernel_launch: hipFuncSetAttribute failed\n"); grid = -1; return; }
        if (hipOccupancyMaxActiveBlocksPerMultiprocessor(&per_cu, (const void*)mega_fwd, 512, LDS_BYTES) != hipSuccess || per_cu < 1) { fprintf(stderr, "kernel_launch: occupancy query gives %d\n", per_cu); per_cu = 1; }
        (void)hipGetLastError();
        grid = cus * 1;
    }
    if (grid < 0) return;
    if (hipMemsetAsync((char*)d_ws + WS_BAR, 0, WS_BAR_BYTES, stream) != hipSuccess) { fprintf(stderr, "kernel_launch: memset of the barrier words failed\n"); return; }
    Args a{};
    for (int i = 0; i < 30; ++i) a.in[i] = (const float*)d_in[i];
    a.out = (float*)d_out; a.ws = (unsigned char*)d_ws;
#if MK_COOP
    a.ph_lo = 0; a.ph_hi = NPH; a.coop = 1;
    void* kargs[] = {&a};
    hipError_t e = hipLaunchCooperativeKernel((const void*)mega_fwd, dim3(grid), dim3(512), kargs, LDS_BYTES, stream);
    if (e != hipSuccess) fprintf(stderr, "kernel_launch: cooperative launch failed: %s (grid %d)\n", hipGetErrorString(e), grid);
#else
    for (int ph = 0; ph < NPH; ++ph) {
        a.ph_lo = ph; a.ph_hi = ph + 1; a.coop = 0;
        hipLaunchKernelGGL(mega_fwd, dim3(grid), dim3(512), LDS_BYTES, stream, a);
    }
#endif
}
```

```cpp
#include <hip/hip_runtime.h>
#include <hip/hip_cooperative_groups.h>
#include <cstdio>
#include <cstdint>
namespace cg = cooperative_groups;

#ifndef MK_COOP
#define MK_COOP 1
#endif
#ifndef PHMASK
#define PHMASK 0x3fff
#endif

#define LAS __attribute__((address_space(3)))
typedef unsigned short bf16_t;
typedef short bf16x8 __attribute__((ext_vector_type(8)));
typedef float f32x4 __attribute__((ext_vector_type(4)));
typedef float f32x16 __attribute__((ext_vector_type(16)));
typedef unsigned u32x4 __attribute__((ext_vector_type(4)));
typedef unsigned u32x2 __attribute__((ext_vector_type(2)));
typedef short s16x4 __attribute__((ext_vector_type(4)));
typedef float f32x2_t __attribute__((ext_vector_type(2)));
typedef __bf16 bf16x2_t __attribute__((ext_vector_type(2)));

constexpr int T = 16384, D = 2048, NS = 128, MR = T + NS, MP = 16640;
constexpr int INW = 4096, PW = 1024, AW = 1024, FF = 5632, MEMW = 512, NMEM = 256, NH = 8, HD = 128;
constexpr float EPS = 1e-6f;
constexpr size_t O_Y = 0, O_YS = (size_t)T * D, O_PSP = O_YS + (size_t)NS * D, O_PWK = O_PSP + 15 * 1024, O_PWV = O_PWK + 2048 * 1024,
                 O_PMK = O_PWV + 2048 * 1024, O_PMV = O_PMK + 256 * 512, O_PSC = O_PMV + 256 * 512, O_SSP = O_PSC + 2 * FF,
                 O_SWK = O_SSP + 32 * 15 * 1024, O_SWV = O_SWK + 32 * 4 * 1024, O_SSC = O_SWV + 32 * 4 * 1024, O_END = O_SSC + 32 * 2 * FF;
constexpr size_t MiB = 1u << 20;
constexpr size_t WS_WIN = 1 * MiB, WS_WOUT = 17 * MiB, WS_WMQ = 25 * MiB, WS_WMKV = 27 * MiB, WS_WMO = 31 * MiB, WS_WGU = 33 * MiB, WS_WDN = 77 * MiB,
                 WS_WPOOL = 99 * MiB, WS_MK = WS_WPOOL + 512 * 1024, WS_MV = WS_MK + 256 * 1024, WS_MN = 100 * MiB, WS_MEMKV = 101 * MiB,
                 WS_CMK = 102 * MiB, WS_CMV = 110 * MiB, WS_LSE = 118 * MiB, WS_H = 120 * MiB, WS_XRES = 185 * MiB, WS_QM = 315 * MiB, WS_OM = 332 * MiB,
                 WS_PROJ = 349 * MiB, WS_QN = 479 * MiB, WS_KN = 512 * MiB, WS_DIFF = 545 * MiB, WS_MIXED = 578 * MiB, WS_OP = 643 * MiB, WS_END = 741 * MiB,
                 WS_G = 349 * MiB, WS_UP = 528 * MiB;
static_assert(WS_UP + (size_t)MP * FF * 2 <= WS_END && WS_G + (size_t)MP * FF * 2 <= WS_UP, "ws map");
constexpr size_t WS_FG = 741 * MiB, WS_FU = 744 * MiB, WS_LG = 747 * MiB, WS_END2 = 750 * MiB;
constexpr size_t WS_BAR = 752 * MiB, WS_BAR_BYTES = 16384, WS_END4 = 753 * MiB;
constexpr size_t WS_SSQ1 = WS_LSE + 1792 * 1024, WS_SSQ2 = WS_SSQ1 + 128 * 1024;
static_assert(3 * (size_t)MP * 8 * 4 <= 1792 * 1024, "lse");
constexpr int LDS_BYTES = 147456;

__device__ const double INVF[64] = {
1.0, 0.8659643233600653, 0.7498942093324559, 0.6493816315762113,
0.5623413251903491, 0.4869675251658631, 0.4216965034285822, 0.3651741272548377,
0.31622776601683794, 0.27384196342643613, 0.23713737056616552, 0.2053525026457146,
0.1778279410038923, 0.1539926526059492, 0.1333521432163324, 0.11547819846894582,
0.1, 0.08659643233600653, 0.07498942093324558, 0.06493816315762113,
0.05623413251903491, 0.04869675251658631, 0.042169650342858224, 0.03651741272548377,
0.03162277660168379, 0.027384196342643614, 0.023713737056616554, 0.02053525026457146,
0.01778279410038923, 0.01539926526059492, 0.01333521432163324, 0.011547819846894581,
0.01, 0.008659643233600654, 0.007498942093324558, 0.006493816315762113,
0.005623413251903491, 0.004869675251658631, 0.004216965034285823, 0.003651741272548377,
0.0031622776601683794, 0.0027384196342643613, 0.0023713737056616554, 0.002053525026457146,
0.0017782794100389228, 0.001539926526059492, 0.001333521432163324, 0.0011547819846894581,
0.001, 0.0008659643233600654, 0.0007498942093324559, 0.0006493816315762113,
0.0005623413251903491, 0.0004869675251658631, 0.00042169650342858224, 0.0003651741272548377,
0.00031622776601683794, 0.0002738419634264361, 0.00023713737056616554, 0.0002053525026457146,
0.00017782794100389227, 0.0001539926526059492, 0.0001333521432163324, 0.00011547819846894582};

__device__ __forceinline__ float bf2f(unsigned b) { return __uint_as_float(b << 16); }
__device__ __forceinline__ unsigned pk2(float lo, float hi) { f32x2_t v = {lo, hi}; bf16x2_t b = __builtin_convertvector(v, bf16x2_t); return __builtin_bit_cast(unsigned, b); }
__device__ __forceinline__ float wave_sum(float v) {
#pragma unroll
    for (int o = 1; o < 64; o <<= 1) v += __shfl_xor(v, o);
    return v;
}
__device__ __forceinline__ void unpack8(u32x4 w, float* f) {
    f[0] = bf2f(w.x & 0xffffu); f[1] = bf2f(w.x >> 16); f[2] = bf2f(w.y & 0xffffu); f[3] = bf2f(w.y >> 16);
    f[4] = bf2f(w.z & 0xffffu); f[5] = bf2f(w.z >> 16); f[6] = bf2f(w.w & 0xffffu); f[7] = bf2f(w.w >> 16);
}
__device__ __forceinline__ u32x4 pack8(const float* f) { u32x4 o; o.x = pk2(f[0], f[1]); o.y = pk2(f[2], f[3]); o.z = pk2(f[4], f[5]); o.w = pk2(f[6], f[7]); return o; }
#define LDS_WAIT() asm volatile("s_waitcnt lgkmcnt(0)" ::: "memory")

namespace pg8 {
constexpr int BM = 256, BK = 64, HALF = 128, HTB = HALF * BK * 2, STAGE_BYTES = 8 * HTB, NXCD = 8, WGM = 8;
__host__ __device__ __forceinline__ int lds_byte(int r, int c) { const int st = (r >> 4) * 2 + (c >> 5), rr = r & 15, cc = c & 31, ob = rr * 64 + cc * 2; return st * 1024 + (ob ^ (((ob >> 9) & 1) << 5)); }
__host__ __device__ __forceinline__ void stage_rc(int b, int& R, int& C) { const int st = b / 1024, sb = b % 1024, swz = sb ^ (((sb >> 9) & 1) << 5); R = (st >> 1) * 16 + swz / 64; C = (st & 1) * 32 + (swz % 64) / 2; }
__host__ __device__ __forceinline__ int perm32(int rho) { const int n = rho >> 4, i = rho & 15; return 8 * (i >> 2) + 4 * n + (i & 3); }
struct Unit { int pm, pn; };
struct Gemm { const bf16_t* A; const bf16_t* Bt; int lda, ldb, K; long a_pn_off; };
struct StaticOrder {
    int nM, nN, nwg, G, c;
    __host__ __device__ void init(int M, int N, int G_, int c_) { nM = M / BM; nN = N / BM; nwg = nM * nN; G = G_; c = c_; }
    __host__ __device__ bool next(int i, Unit& u) const {
        const long L = (long)i * G + c; if (L >= nwg) return false;
        int wgid = (int)L; { const int q = nwg / NXCD, r = nwg % NXCD, xcd = wgid % NXCD, off = wgid / NXCD; wgid = (xcd < r ? xcd * (q + 1) : r * (q + 1) + (xcd - r) * q) + off; }
        const int nig = WGM * nN, gid = wgid / nig, fm = gid * WGM, gsz = (nM - fm) < WGM ? (nM - fm) : WGM;
        u.pm = fm + ((wgid % nig) % gsz); u.pn = (wgid % nig) / gsz; return true;
    }
};
struct EpiBf16 {
    static constexpr bool PERM = true;
    bf16_t* O; int ldc;
    __device__ __forceinline__ void operator()(const f32x4 (&acc)[2][2][4][2], const Unit& u, int wr, int wc, int fr, int fq) const {
        const int row0 = u.pm * BM + wr * 64 + fr, col0 = u.pn * BM + wc * 32 + 8 * fq;
#pragma unroll
        for (int ai = 0; ai < 2; ++ai)
#pragma unroll
            for (int m = 0; m < 4; ++m) { bf16_t* rowp = O + (size_t)(row0 + ai * HALF + m * 16) * ldc + col0;
#pragma unroll
                for (int bj = 0; bj < 2; ++bj) { const f32x4 v0 = acc[ai][bj][m][0], v1 = acc[ai][bj][m][1];
                    u32x4 w; w.x = pk2(v0[0], v0[1]); w.y = pk2(v0[2], v0[3]); w.z = pk2(v1[0], v1[1]); w.w = pk2(v1[2], v1[3]);
                    *(u32x4*)(rowp + bj * HALF) = w; } }
    }
};
struct EpiGU {
    static constexpr bool PERM = true;
    bf16_t* G; bf16_t* UP; const float* ssq;
    __device__ __forceinline__ void operator()(const f32x4 (&acc)[2][2][4][2], const Unit& u, int wr, int wc, int fr, int fq) const {
        const int row0 = u.pm * BM + wr * 64 + fr, col0 = u.pn * HALF + wc * 32 + 8 * fq;
#pragma unroll
        for (int ai = 0; ai < 2; ++ai)
#pragma unroll
            for (int m = 0; m < 4; ++m) { const size_t off = (size_t)(row0 + ai * HALF + m * 16) * FF + col0; const f32x4 q0 = *(const f32x4*)(ssq + (size_t)(row0 + ai * HALF + m * 16) * 8), q1 = *(const f32x4*)(ssq + (size_t)(row0 + ai * HALF + m * 16) * 8 + 4); const float rs = rsqrtf(((q0.x + q0.y) + (q0.z + q0.w) + (q1.x + q1.y) + (q1.z + q1.w)) * (1.f / D) + EPS);
#pragma unroll
                for (int bj = 0; bj < 2; ++bj) { const f32x4 v0 = acc[ai][bj][m][0] * rs, v1 = acc[ai][bj][m][1] * rs;
                    u32x4 w; w.x = pk2(v0[0], v0[1]); w.y = pk2(v0[2], v0[3]); w.z = pk2(v1[0], v1[1]); w.w = pk2(v1[2], v1[3]);
                    *(u32x4*)((bj ? UP : G) + off) = w; } }
    }
};
struct EpiF32 {
    static constexpr bool PERM = false;
    float* O; int ldc;
    __device__ __forceinline__ void operator()(const f32x4 (&acc)[2][2][4][2], const Unit& u, int wr, int wc, int fr, int fq) const {
        const int row0 = u.pm * BM + wr * 64 + fr, col0 = u.pn * BM + wc * 32 + 4 * fq;
#pragma unroll
        for (int ai = 0; ai < 2; ++ai)
#pragma unroll
            for (int m = 0; m < 4; ++m) { float* rowp = O + (size_t)(row0 + ai * HALF + m * 16) * ldc + col0;
#pragma unroll
                for (int bj = 0; bj < 2; ++bj)
#pragma unroll
                    for (int n = 0; n < 2; ++n) *(f32x4*)(rowp + bj * HALF + n * 16) = acc[ai][bj][m][n]; }
    }
};
struct EpiRes {
    static constexpr bool PERM = false;
    const float* base0; const float* base1; int split; float* out; int nrows;
    __device__ __forceinline__ void operator()(const f32x4 (&acc)[2][2][4][2], const Unit& u, int wr, int wc, int fr, int fq) const {
        const int row0 = u.pm * BM + wr * 64 + fr, col0 = u.pn * BM + wc * 32 + 4 * fq;
#pragma unroll
        for (int ai = 0; ai < 2; ++ai)
#pragma unroll
            for (int m = 0; m < 4; ++m) { const int row = row0 + ai * HALF + m * 16;
                if (row < nrows) {
                    const float* bp = (row < split ? base0 + (size_t)row * D : base1 + (size_t)(row - split) * D) + col0; float* op = out + (size_t)row * D + col0;
#pragma unroll
                    for (int bj = 0; bj < 2; ++bj)
#pragma unroll
                        for (int n = 0; n < 2; ++n) { const f32x4 b = *(const f32x4*)(bp + bj * HALF + n * 16); *(f32x4*)(op + bj * HALF + n * 16) = b + acc[ai][bj][m][n]; } } }
    }
};

__device__ __forceinline__ float dpp_ror1(float x) { return __int_as_float(__builtin_amdgcn_update_dpp(0, __float_as_int(x), 0x121, 0xf, 0xf, false)); }
__device__ __forceinline__ float dpp_ror2(float x) { return __int_as_float(__builtin_amdgcn_update_dpp(0, __float_as_int(x), 0x122, 0xf, 0xf, false)); }
struct EpiGUConv {
    static constexpr bool PERM = true;
    bf16_t* ACT; const float* pssq; const float* cw; const float* cb; float* firstg; float* firstup; float* lastg; LAS float* X;
    __device__ __forceinline__ float rsq(int row) const { const f32x4 q0 = *(const f32x4*)(pssq + (size_t)row * 8), q1 = *(const f32x4*)(pssq + (size_t)row * 8 + 4);
        return rsqrtf(((q0.x + q0.y) + (q0.z + q0.w) + (q1.x + q1.y) + (q1.z + q1.w)) * (1.f / D) + EPS); }
    __device__ __forceinline__ void operator()(const f32x4 (&acc)[2][2][4][2], const Unit& u, int wr, int wc, int fr, int fq) const {
        const int ch0 = u.pn * HALF + wc * 32 + 8 * fq, rowb = u.pm * BM + wr * 64 + fr;
        f32x4 w0[2], w1[2], w2[2], bb[2];
#pragma unroll
        for (int n = 0; n < 2; ++n) { w0[n] = *(const f32x4*)(cw + ch0 + 4 * n); w1[n] = *(const f32x4*)(cw + FF + ch0 + 4 * n); w2[n] = *(const f32x4*)(cw + 2 * FF + ch0 + 4 * n); bb[n] = *(const f32x4*)(cb + ch0 + 4 * n); }
#pragma unroll
        for (int ai = 0; ai < 2; ++ai) { const float rs = rsq(rowb + ai * HALF + 48);
            if (fr >= 14) {
#pragma unroll
                for (int n = 0; n < 2; ++n) *(LAS f32x4*)(X + ((((ai * 2 + wr) * 4 + wc) * 2 + (fr - 14)) * 32 + 8 * fq + 4 * n)) = acc[ai][0][3][n] * rs; } }
        asm volatile("s_waitcnt lgkmcnt(0)" ::: "memory"); __builtin_amdgcn_s_barrier(); asm volatile("" ::: "memory");
#pragma unroll
        for (int ai = 0; ai < 2; ++ai) {
            f32x4 gprev[2];
            if (wr == 1 || ai == 1) { const int sai = (wr == 1) ? ai : ai - 1, swr = (wr == 1) ? 0 : 1; const LAS float* xp = X + (((sai * 2 + swr) * 4 + wc) * 2) * 32 + 8 * fq;
#pragma unroll
                for (int n = 0; n < 2; ++n) { const f32x4 h2 = *(const LAS f32x4*)(xp + 4 * n), h1 = *(const LAS f32x4*)(xp + 32 + 4 * n); gprev[n] = (fr == 15) ? h1 : h2; } }
            else { gprev[0] = (f32x4){0.f, 0.f, 0.f, 0.f}; gprev[1] = gprev[0]; }
#pragma unroll
            for (int m = 0; m < 4; ++m) { const int row = rowb + ai * HALF + m * 16; const float rs = rsq(row);
                f32x4 g[2], a[2];
#pragma unroll
                for (int n = 0; n < 2; ++n) { g[n] = acc[ai][0][m][n] * rs; const f32x4 up = acc[ai][1][m][n] * rs;
#pragma unroll
                    for (int e = 0; e < 4; ++e) { const float r1c = dpp_ror1(g[n][e]), r1p = dpp_ror1(gprev[n][e]), r2c = dpp_ror2(g[n][e]), r2p = dpp_ror2(gprev[n][e]);
                        const float p1 = fr >= 1 ? r1c : r1p, p2 = fr >= 2 ? r2c : r2p;
                        const float c = bb[n][e] + w0[n][e] * p2 + w1[n][e] * p1 + w2[n][e] * g[n][e]; a[n][e] = c / (1.f + __expf(-c)) * up[e]; }
                    if (ai == 0 && m == 0 && wr == 0 && fr < 2) { *(f32x4*)(firstg + ((size_t)u.pm * 2 + fr) * FF + ch0 + 4 * n) = g[n]; *(f32x4*)(firstup + ((size_t)u.pm * 2 + fr) * FF + ch0 + 4 * n) = up; }
                    if (ai == 1 && m == 3 && wr == 1 && fr >= 14) *(f32x4*)(lastg + ((size_t)u.pm * 2 + (fr - 14)) * FF + ch0 + 4 * n) = g[n]; }
                if (!(ai == 0 && m == 0 && wr == 0 && fr < 2)) { u32x4 w; w.x = pk2(a[0][0], a[0][1]); w.y = pk2(a[0][2], a[0][3]); w.z = pk2(a[1][0], a[1][1]); w.w = pk2(a[1][2], a[1][3]);
                    *(u32x4*)(ACT + (size_t)row * FF + ch0) = w; }
                gprev[0] = g[0]; gprev[1] = g[1]; }
        }
    }
};

struct EpiResN {
    static constexpr bool PERM = false;
    const float* base; float* out; bf16_t* xb; float* pssq; LAS float* sred;
    __device__ __forceinline__ void operator()(const f32x4 (&acc)[2][2][4][2], const Unit& u, int wr, int wc, int fr, int fq) const {
        const int row0 = u.pm * BM + wr * 64 + fr, col0 = u.pn * BM + wc * 32 + 4 * fq;
#pragma unroll
        for (int ai = 0; ai < 2; ++ai)
#pragma unroll
            for (int m = 0; m < 4; ++m) { const int row = row0 + ai * HALF + m * 16;
                const float* bp = base + (size_t)row * D + col0; float* op = out + (size_t)row * D + col0; bf16_t* xp = xb + (size_t)row * D + col0;
                float ss = 0.f;
#pragma unroll
                for (int bj = 0; bj < 2; ++bj)
#pragma unroll
                    for (int n = 0; n < 2; ++n) { const f32x4 b = *(const f32x4*)(bp + bj * HALF + n * 16); const f32x4 x = b + acc[ai][bj][m][n]; *(f32x4*)(op + bj * HALF + n * 16) = x;
                        u32x2 w; w.x = pk2(x.x, x.y); w.y = pk2(x.z, x.w); *(u32x2*)(xp + bj * HALF + n * 16) = w; ss += (x.x * x.x + x.y * x.y) + (x.z * x.z + x.w * x.w); }
                ss += __shfl_xor(ss, 16); ss += __shfl_xor(ss, 32);
                if (fq == 0) sred[wc * 256 + ai * HALF + wr * 64 + m * 16 + fr] = ss; }
        asm volatile("s_waitcnt lgkmcnt(0)" ::: "memory"); __builtin_amdgcn_s_barrier(); asm volatile("" ::: "memory");
        const int t = threadIdx.x;
        if (t < 256) pssq[(size_t)(u.pm * BM + t) * 8 + u.pn] = (sred[t] + sred[256 + t]) + (sred[512 + t] + sred[768 + t]);
    }
};

template <class Epi, class Sched>
__device__ __forceinline__ void gemm_phase(LAS unsigned char* lds, const Gemm g, const Sched& S, const Epi& E) {
    const int tid = threadIdx.x, wid = __builtin_amdgcn_readfirstlane(tid >> 6), lane = tid & 63, wr = wid >> 2, wc = wid & 3, fr = lane & 15, fq = lane >> 4;
    const int K = g.K, nt = K / BK;
    unsigned voffA[2], voffB[2];
#pragma unroll
    for (int i = 0; i < 2; ++i) { int R, C; stage_rc(tid * 16 + i * 8192, R, C); const int Rb = Epi::PERM ? ((R & ~31) + perm32(R & 31)) : R;
        voffA[i] = (unsigned)(R * g.lda + C) * 2u; voffB[i] = (unsigned)(Rb * g.ldb + C) * 2u; }
    const size_t kstep = (size_t)(BK * 2);
    const size_t hstepA = (size_t)HALF * g.lda * 2, hstepB = (size_t)HALF * g.ldb * 2;
    const size_t tstepA = 2 * hstepA, tstepB = 2 * hstepB;
    const unsigned ldsw = (unsigned)wid * 1024u;
    const int aoff = lds_byte(wr * 64 + fr, fq * 8), boff = lds_byte(wc * 32 + fr, fq * 8);
#define PG8_SA(b, h) (((b) * 2 + (h)) * HTB)
#define PG8_SB(b, h) ((4 + (b) * 2 + (h)) * HTB)
#define PG8_STAGE(bufoff, gbase, voff) do { _Pragma("unroll") for (int _i = 0; _i < 2; ++_i) \
        __builtin_amdgcn_global_load_lds((const unsigned*)((const char*)(gbase) + (voff)[_i]), (LAS unsigned*)(lds + (bufoff) + ldsw + _i * 8192), 16, 0, 0); } while (0)
#define PG8_LDA(dst, b, h) do { _Pragma("unroll") for (int m = 0; m < 4; ++m) _Pragma("unroll") for (int k = 0; k < 2; ++k) dst[m][k] = *(const LAS bf16x8*)(lds + PG8_SA(b, h) + aoff + m * 2048 + k * 1024); } while (0)
#define PG8_LDB(dst, b, h) do { _Pragma("unroll") for (int n = 0; n < 2; ++n) _Pragma("unroll") for (int k = 0; k < 2; ++k) dst[n][k] = *(const LAS bf16x8*)(lds + PG8_SB(b, h) + boff + n * 2048 + k * 1024); } while (0)
#define PG8_MMA(ai, bj, At, Bt) do { __builtin_amdgcn_s_setprio(1); _Pragma("unroll") for (int m = 0; m < 4; ++m) _Pragma("unroll") for (int n = 0; n < 2; ++n) _Pragma("unroll") for (int k = 0; k < 2; ++k) \
        acc[ai][bj][m][n] = __builtin_amdgcn_mfma_f32_16x16x32_bf16(Bt[n][k], At[m][k], acc[ai][bj][m][n], 0, 0, 0); __builtin_amdgcn_s_setprio(0); } while (0)
#define PG8_WAIT_V(n) asm volatile("s_waitcnt vmcnt(" #n ")" ::: "memory")
#define PG8_WAIT_L(n) asm volatile("s_waitcnt lgkmcnt(" #n ")" ::: "memory")
#define PG8_BAR __builtin_amdgcn_s_barrier()
#define PG8_SCHED __builtin_amdgcn_sched_barrier(0)
    Unit cur, nxt; int ui = 0;
    if (!S.next(0, cur)) return;
    f32x4 acc[2][2][4][2];
#pragma unroll
    for (int a = 0; a < 2; ++a)
#pragma unroll
        for (int b = 0; b < 2; ++b)
#pragma unroll
            for (int m = 0; m < 4; ++m)
#pragma unroll
                for (int n = 0; n < 2; ++n) acc[a][b][m][n] = (f32x4){0.f, 0.f, 0.f, 0.f};
    bf16x8 At[4][2], B0[2][2], B1[2][2];
    const char* cA = (const char*)g.A + (size_t)cur.pm * tstepA + (size_t)cur.pn * g.a_pn_off; const char* cB = (const char*)g.Bt + (size_t)cur.pn * tstepB;
    PG8_STAGE(PG8_SB(0, 0), cB, voffB); PG8_STAGE(PG8_SB(0, 1), cB + hstepB, voffB); PG8_STAGE(PG8_SA(0, 0), cA, voffA); PG8_STAGE(PG8_SA(0, 1), cA + hstepA, voffA);
    if (wr == 1) PG8_BAR;
    PG8_WAIT_V(2); PG8_BAR;
    PG8_STAGE(PG8_SB(1, 0), cB + kstep, voffB); PG8_STAGE(PG8_SA(1, 0), cA + kstep, voffA); PG8_STAGE(PG8_SB(1, 1), cB + hstepB + kstep, voffB);
    PG8_WAIT_V(6); PG8_BAR;
    for (;;) {
        const bool has_next = S.next(ui + 1, nxt);
        const char* nA = has_next ? (const char*)g.A + (size_t)nxt.pm * tstepA + (size_t)nxt.pn * g.a_pn_off : cA; const char* nB = has_next ? (const char*)g.Bt + (size_t)nxt.pn * tstepB : cB;
        for (int t = 0; t < nt; t += 2) {
            const bool last = (t == nt - 2);
            const char* a1 = cA + (size_t)(t + 1) * kstep;
            const char* a2 = last ? nA : cA + (size_t)(t + 2) * kstep; const char* b2 = last ? nB : cB + (size_t)(t + 2) * kstep;
            const char* a3 = a2 + kstep; const char* b3 = b2 + kstep;
            PG8_LDB(B0, 0, 0); PG8_LDB(B1, 0, 1); PG8_SCHED; PG8_LDA(At, 0, 0); PG8_STAGE(PG8_SA(1, 1), a1 + hstepA, voffA);
            PG8_WAIT_V(8); PG8_WAIT_L(0); PG8_BAR; PG8_MMA(0, 0, At, B0); PG8_MMA(0, 1, At, B1); PG8_BAR; PG8_SCHED;
            PG8_LDA(At, 0, 1); PG8_STAGE(PG8_SB(0, 0), b2, voffB); PG8_STAGE(PG8_SB(0, 1), b2 + hstepB, voffB); PG8_STAGE(PG8_SA(0, 0), a2, voffA);
            PG8_WAIT_V(8); PG8_WAIT_L(0); PG8_BAR; PG8_MMA(1, 0, At, B0); PG8_MMA(1, 1, At, B1); PG8_BAR; PG8_SCHED;
            PG8_LDB(B0, 1, 0); PG8_LDB(B1, 1, 1); PG8_SCHED; PG8_LDA(At, 1, 0); PG8_STAGE(PG8_SA(0, 1), a2 + hstepA, voffA);
            PG8_WAIT_V(8); PG8_WAIT_L(0); PG8_BAR; PG8_MMA(0, 0, At, B0); PG8_MMA(0, 1, At, B1); PG8_BAR; PG8_SCHED;
            PG8_LDA(At, 1, 1); PG8_STAGE(PG8_SB(1, 0), b3, voffB); PG8_STAGE(PG8_SB(1, 1), b3 + hstepB, voffB); PG8_STAGE(PG8_SA(1, 0), a3, voffA);
            PG8_WAIT_V(8); PG8_WAIT_L(0); PG8_BAR; PG8_MMA(1, 0, At, B0); PG8_MMA(1, 1, At, B1); PG8_BAR; PG8_SCHED;
        }
        if (wr == 0) PG8_BAR;
        E(acc, cur, wr, wc, fr, fq);
        if (!has_next) break;
#pragma unroll
        for (int a = 0; a < 2; ++a)
#pragma unroll
            for (int b = 0; b < 2; ++b)
#pragma unroll
                for (int m = 0; m < 4; ++m)
#pragma unroll
                    for (int n = 0; n < 2; ++n) acc[a][b][m][n] = (f32x4){0.f, 0.f, 0.f, 0.f};
        cur = nxt; cA = nA; cB = nB; ++ui;
        if (wr == 1) PG8_BAR;
    }
    PG8_WAIT_V(0);
    PG8_BAR;
#undef PG8_SA
#undef PG8_SB
#undef PG8_STAGE
#undef PG8_LDA
#undef PG8_LDB
#undef PG8_MMA
#undef PG8_WAIT_V
#undef PG8_WAIT_L
#undef PG8_BAR
#undef PG8_SCHED
}
}


template <int NT, class Epi>
__device__ __forceinline__ void skinny_gemm_nt(LAS unsigned char* lds, const bf16_t* A, int lda, const bf16_t* Wt, int ldb, int K, int nct, int nrh, int bx, int G, int wave, int lane, int tid, const Epi& E) {
    LAS float* red = (LAS float*)lds;
    const int fr = lane & 15, fq = lane >> 4, kw = K / 8, ngrp = (nct + NT - 1) / NT;
    for (int item = bx; item < ngrp * nrh; item += G) {
        const int ctg = item % ngrp, rh = item / ngrp;
        f32x4 acc[NT][8];
#pragma unroll
        for (int t = 0; t < NT; ++t)
#pragma unroll
            for (int rb = 0; rb < 8; ++rb) acc[t][rb] = (f32x4){0.f, 0.f, 0.f, 0.f};
        const bf16_t* bpt[NT];
#pragma unroll
        for (int t = 0; t < NT; ++t) { const int ctt = ctg * NT + t < nct ? ctg * NT + t : nct - 1; bpt[t] = Wt + (size_t)(ctt * 16 + fr) * ldb + wave * kw + fq * 8; }
        const bf16_t* ap = A + (size_t)(rh * 128 + fr) * lda + wave * kw + fq * 8;
        bf16x8 b[NT], a[8];
#pragma unroll
        for (int t = 0; t < NT; ++t) b[t] = *(const bf16x8*)(bpt[t]);
#pragma unroll
        for (int rb = 0; rb < 8; ++rb) a[rb] = *(const bf16x8*)(ap + (size_t)rb * 16 * lda);
        for (int k = 0; k < kw; k += 32) {
            bf16x8 nb[NT], na[8];
#pragma unroll
            for (int t = 0; t < NT; ++t) nb[t] = b[t];
#pragma unroll
            for (int rb = 0; rb < 8; ++rb) na[rb] = a[rb];
            if (k + 32 < kw) {
#pragma unroll
                for (int t = 0; t < NT; ++t) nb[t] = *(const bf16x8*)(bpt[t] + k + 32);
#pragma unroll
                for (int rb = 0; rb < 8; ++rb) na[rb] = *(const bf16x8*)(ap + (size_t)rb * 16 * lda + k + 32);
            }
#pragma unroll
            for (int t = 0; t < NT; ++t)
#pragma unroll
                for (int rb = 0; rb < 8; ++rb) acc[t][rb] = __builtin_amdgcn_mfma_f32_16x16x32_bf16(a[rb], b[t], acc[t][rb], 0, 0, 0);
#pragma unroll
            for (int t = 0; t < NT; ++t) b[t] = nb[t];
#pragma unroll
            for (int rb = 0; rb < 8; ++rb) a[rb] = na[rb];
        }
#pragma unroll
        for (int t = 0; t < NT; ++t) {
#pragma unroll
            for (int rb = 0; rb < 8; ++rb)
#pragma unroll
                for (int j = 0; j < 4; ++j) red[(wave * 128 + rb * 16 + 4 * fq + j) * 16 + fr] = acc[t][rb][j];
            __syncthreads();
            if (ctg * NT + t < nct) { const int e = tid * 4, row = e >> 4, col = e & 15;
                f32x4 v = *(const LAS f32x4*)(red + row * 16 + col);
#pragma unroll
                for (int w = 1; w < 8; ++w) v += *(const LAS f32x4*)(red + (w * 128 + row) * 16 + col);
                E(row, rh, (ctg * NT + t) * 16 + col, v); }
            __syncthreads();
        }
    }
}
template <int RB = 8, class Epi>
__device__ __forceinline__ void skinny_gemm(LAS unsigned char* lds, const bf16_t* A, int lda, const bf16_t* Wt, int ldb, int K, int nct, int nrh, int bx, int G, int wave, int lane, int tid, const Epi& E) {
    LAS float* red = (LAS float*)lds;
    const int fr = lane & 15, fq = lane >> 4, kw = K / 8;
    for (int item = bx; item < nct * nrh * (8 / RB); item += G) {
        const int ct = item % nct, rs = item / nct, row0 = rs * RB * 16, rh = row0 >> 7, rin = row0 & 127;
        f32x4 acc[RB];
#pragma unroll
        for (int rb = 0; rb < RB; ++rb) acc[rb] = (f32x4){0.f, 0.f, 0.f, 0.f};
        const bf16_t* bp = Wt + (size_t)(ct * 16 + fr) * ldb + wave * kw + fq * 8;
        const bf16_t* ap = A + (size_t)(row0 + fr) * lda + wave * kw + fq * 8;
        bf16x8 b0 = *(const bf16x8*)(bp), b1 = *(const bf16x8*)(bp + 32), a0[RB], a1[RB];
#pragma unroll
        for (int rb = 0; rb < RB; ++rb) { a0[rb] = *(const bf16x8*)(ap + (size_t)rb * 16 * lda); a1[rb] = *(const bf16x8*)(ap + (size_t)rb * 16 * lda + 32); }
        for (int k = 0; k < kw; k += 64) {
            bf16x8 nb0 = b0, nb1 = b1, na0[RB], na1[RB];
#pragma unroll
            for (int rb = 0; rb < RB; ++rb) { na0[rb] = a0[rb]; na1[rb] = a1[rb]; }
            if (k + 64 < kw) {
                nb0 = *(const bf16x8*)(bp + k + 64); nb1 = *(const bf16x8*)(bp + k + 96);
#pragma unroll
                for (int rb = 0; rb < RB; ++rb) { na0[rb] = *(const bf16x8*)(ap + (size_t)rb * 16 * lda + k + 64); na1[rb] = *(const bf16x8*)(ap + (size_t)rb * 16 * lda + k + 96); }
            }
#pragma unroll
            for (int rb = 0; rb < RB; ++rb) acc[rb] = __builtin_amdgcn_mfma_f32_16x16x32_bf16(a0[rb], b0, acc[rb], 0, 0, 0);
#pragma unroll
            for (int rb = 0; rb < RB; ++rb) acc[rb] = __builtin_amdgcn_mfma_f32_16x16x32_bf16(a1[rb], b1, acc[rb], 0, 0, 0);
            b0 = nb0; b1 = nb1;
#pragma unroll
            for (int rb = 0; rb < RB; ++rb) { a0[rb] = na0[rb]; a1[rb] = na1[rb]; }
        }
#pragma unroll
        for (int rb = 0; rb < RB; ++rb)
#pragma unroll
            for (int j = 0; j < 4; ++j) red[(wave * (RB * 16) + rb * 16 + 4 * fq + j) * 16 + fr] = acc[rb][j];
        __syncthreads();
        if (tid < RB * 64) { const int e = tid * 4, row = e >> 4, col = e & 15;
            f32x4 v = *(const LAS f32x4*)(red + row * 16 + col);
#pragma unroll
            for (int w = 1; w < 8; ++w) v += *(const LAS f32x4*)(red + (w * (RB * 16) + row) * 16 + col);
            E(rin + row, rh, ct * 16 + col, v); }
        __syncthreads();
    }
}
struct SkBf16 { bf16_t* O; int ldc; __device__ __forceinline__ void operator()(int row, int rh, int col, f32x4 v) const { u32x2 w; w.x = pk2(v.x, v.y); w.y = pk2(v.z, v.w); *(u32x2*)(O + (size_t)(rh * 128 + row) * ldc + col) = w; } };
struct SkF32 { float* O; int ldc; __device__ __forceinline__ void operator()(int row, int rh, int col, f32x4 v) const { *(f32x4*)(O + (size_t)(rh * 128 + row) * ldc + col) = v; } };
struct SkRes { const float* base; float* O; __device__ __forceinline__ void operator()(int row, int rh, int col, f32x4 v) const { const f32x4 b = *(const f32x4*)(base + (size_t)row * D + col); *(f32x4*)(O + (size_t)row * D + col) = b + v; } };
struct SkResN { const float* base; float* O; bf16_t* xb; float* ssq; __device__ __forceinline__ void operator()(int row, int rh, int col, f32x4 v) const { const f32x4 b = *(const f32x4*)(base + (size_t)row * D + col); const f32x4 x = b + v;
    *(f32x4*)(O + (size_t)row * D + col) = x; u32x2 w; w.x = pk2(x.x, x.y); w.y = pk2(x.z, x.w); *(u32x2*)(xb + (size_t)row * D + col) = w; float ss = (x.x * x.x + x.y * x.y) + (x.z * x.z + x.w * x.w); ss += __shfl_xor(ss, 1); ss += __shfl_xor(ss, 2); if ((col & 15) == 0) atomicAdd(ssq + row, ss); } };
struct SkGU { bf16_t* Gp; bf16_t* Up; const float* ssq; __device__ __forceinline__ void operator()(int row, int rh, int col, f32x4 v) const { const int ch = (col >> 8) * 128 + (col & 127); v = v * rsqrtf(ssq[row] * (1.f / D) + EPS); u32x2 w; w.x = pk2(v.x, v.y); w.y = pk2(v.z, v.w);
    *(u32x2*)(Gp + (size_t)((col >> 7) & 1) * ((WS_UP - WS_G) / 2) + (size_t)row * FF + ch) = w; } };

typedef __attribute__((address_space(1))) unsigned gu32;
#define RLX_AGENT __ATOMIC_RELAXED, __HIP_MEMORY_SCOPE_AGENT
#define XB_TMO      128
#define XB_XCNT(j)  (256  + 64 * (j))
#define XB_XSUB(j)  (1280 + 64 * (j))
#define XB_XGEN(j)  (2304 + 64 * (j))
#define XB_TOP      3328
#define XB_TOPGEN   3392
#define XCD_BAR_WORDS 3456
#define XB_SPIN_CAP (1u << 18)

__device__ __forceinline__ unsigned xb_ld(unsigned* p)              { return __hip_atomic_load(p, __ATOMIC_RELAXED, __HIP_MEMORY_SCOPE_AGENT); }
__device__ __forceinline__ unsigned xb_add(unsigned* p, unsigned v) { return __hip_atomic_fetch_add(p, v, __ATOMIC_RELAXED, __HIP_MEMORY_SCOPE_AGENT); }
__device__ __forceinline__ unsigned xb_xcc_id() { return (unsigned)__builtin_amdgcn_s_getreg((3 << 11) | 20) & 0xFu; }
#define XB_SPIN(cond, bar) do { unsigned _sp = 0; while (cond) { __builtin_amdgcn_s_sleep(1); \
    if ((++_sp & 255u) == 0u) { if (xb_ld(&(bar)[XB_TMO])) break; if (_sp > XB_SPIN_CAP) { atomicAdd(&(bar)[XB_TMO], 1u); break; } } } } while (0)

struct XcdBarrier {
    unsigned* bar; unsigned x;
    volatile LAS unsigned* st;
};

__device__ __forceinline__ XcdBarrier xcd_barrier_post(unsigned* bar, volatile LAS unsigned* st) {
    XcdBarrier b; b.bar = bar; b.x = xb_xcc_id(); b.st = st;
    if (threadIdx.x == 0) (void)xb_add(&bar[XB_XCNT(b.x)], 1u);
    return b;
}
__device__ __forceinline__ void xcd_barrier_complete(unsigned* bar, unsigned x, unsigned& nloc, unsigned& nx) {
    const unsigned G = gridDim.x * gridDim.y * gridDim.z;
    unsigned sum, cnt, mine, sp = 0u;
    for (;;) {
        sum = 0u; cnt = 0u; mine = 0u;
#pragma unroll
        for (unsigned j = 0; j < 16; ++j) { const unsigned c = xb_ld(&bar[XB_XCNT(j)]); sum += c; cnt += (c > 0u) ? 1u : 0u; mine = (j == x) ? c : mine; }
        if (sum == G) break;
        __builtin_amdgcn_s_sleep(1);
        if ((++sp & 255u) == 0u) { if (xb_ld(&bar[XB_TMO])) break; if (sp > XB_SPIN_CAP) { atomicAdd(&bar[XB_TMO], 1u); break; } }
    }
    nloc = mine > 0u ? mine : 1u; nx = cnt > 0u ? cnt : 1u;
}

__device__ __forceinline__ void xcd_barrier(const XcdBarrier& b) {
    asm volatile("s_waitcnt vmcnt(0)" ::: "memory");
    __syncthreads();
    if (threadIdx.x == 0) {
        unsigned* bar = b.bar;
        __builtin_amdgcn_s_waitcnt(0);
        unsigned nloc = b.st[0], nx = b.st[1];
        if (nloc == 0u) { xcd_barrier_complete(bar, b.x, nloc, nx); b.st[0] = nloc; b.st[1] = nx; }
        const unsigned old = xb_add(&bar[XB_XSUB(b.x)], 1u);
        const unsigned gen = old / nloc;
        if (old + 1u == (gen + 1u) * nloc) {
            __builtin_amdgcn_fence(__ATOMIC_RELEASE, "agent");
            asm volatile("s_waitcnt vmcnt(0)" ::: "memory");
            const unsigned og = xb_add(&bar[XB_TOP], 1u);
            const unsigned tg = og / nx;
            if (og + 1u == (tg + 1u) * nx) xb_add(&bar[XB_TOPGEN], 1u);
            else XB_SPIN(xb_ld(&bar[XB_TOPGEN]) == tg, bar);
            __builtin_amdgcn_fence(__ATOMIC_ACQUIRE, "agent");
            xb_add(&bar[XB_XGEN(b.x)], 1u);
            asm volatile("s_waitcnt vmcnt(0)" ::: "memory");
        } else {
            XB_SPIN(xb_ld(&bar[XB_XGEN(b.x)]) == gen, bar);
            __builtin_amdgcn_fence(__ATOMIC_ACQUIRE, "agent");
            asm volatile("s_waitcnt vmcnt(0)" ::: "memory");
        }
    }
    __syncthreads();
}

struct Args { const float* in[30]; float* out; unsigned char* ws; int ph_lo, ph_hi, coop, pad; };

__device__ __forceinline__ void transpose_item(const float* W, int N, bf16_t* WT, int ldk, int out_row0, int k0, int n0, const float* nscale, const float* kscale, LAS float* scr, int lane) {
    f32x4 v[16];
#pragma unroll
    for (int i = 0; i < 16; ++i) v[i] = *(const f32x4*)(W + (size_t)(k0 + (lane >> 4) + 4 * i) * N + n0 + 4 * (lane & 15));
#pragma unroll
    for (int i = 0; i < 16; ++i) { const int kk = (lane >> 4) + 4 * i; const float ks = kscale ? kscale[k0 + kk] : 1.f;
        *(LAS f32x4*)(scr + kk * 68 + ((4 * (lane & 15)) ^ (4 * ((kk >> 3) & 7)))) = v[i] * ks; }
    LDS_WAIT();
    const int c = lane & 7;
#pragma unroll
    for (int j = 0; j < 8; ++j) { const int n = (lane >> 3) + 8 * j; const LAS float* sp = scr + (8 * c) * 68 + (n ^ (4 * c)); const float sc = nscale ? nscale[out_row0 + n] : 1.f;
        u32x4 o; o.x = pk2(sp[0 * 68] * sc, sp[1 * 68] * sc); o.y = pk2(sp[2 * 68] * sc, sp[3 * 68] * sc); o.z = pk2(sp[4 * 68] * sc, sp[5 * 68] * sc); o.w = pk2(sp[6 * 68] * sc, sp[7 * 68] * sc);
        *(u32x4*)(WT + (size_t)(out_row0 + n) * ldk + k0 + 8 * c) = o; }
    LDS_WAIT();
}
__device__ __forceinline__ void transpose_mat(const float* W, int K, int N, bf16_t* WT, int mode, int row_off, const float* nscale, const float* kscale, int r, LAS float* scr, int lane) {
    const int nnb = N / 64, kb = r / nnb, nb = r % nnb, n0 = nb * 64, k0 = kb * 64;
    const int orow = mode == 0 ? row_off + n0 : (mode == 1 ? (n0 >> 7) * 256 + (n0 & 127) : (n0 >> 7) * 256 + 128 + (n0 & 127));
    transpose_item(W, N, WT, K, orow, k0, n0, nscale, kscale, scr, lane);
}
__device__ __forceinline__ void rms_row(const float* x, const float* gain, bf16_t* o, int lane) {
    f32x4 v[8]; float s = 0.f;
#pragma unroll
    for (int j = 0; j < 8; ++j) { v[j] = ((const f32x4*)x)[lane + 64 * j]; s += (v[j].x * v[j].x + v[j].y * v[j].y) + (v[j].z * v[j].z + v[j].w * v[j].w); }
    const float r = rsqrtf(wave_sum(s) * (1.f / D) + EPS);
#pragma unroll
    for (int j = 0; j < 8; ++j) { const f32x4 gn = ((const f32x4*)gain)[lane + 64 * j]; u32x2 w; w.x = pk2(v[j].x * r * gn.x, v[j].y * r * gn.y); w.y = pk2(v[j].z * r * gn.z, v[j].w * r * gn.w);
        ((u32x2*)o)[lane + 64 * j] = w; }
}

__device__ __forceinline__ int crow(int r, int hi) { return (r & 3) + 8 * (r >> 2) + 4 * hi; }
template <bool F32> __device__ __forceinline__ bf16x8 ld8(const void* p) {
    if constexpr (F32) { const f32x4 a = ((const f32x4*)p)[0], b = ((const f32x4*)p)[1]; u32x4 o; o.x = pk2(a.x, a.y); o.y = pk2(a.z, a.w); o.z = pk2(b.x, b.y); o.w = pk2(b.z, b.w); return __builtin_bit_cast(bf16x8, o); }
    else return *(const bf16x8*)p;
}
struct KVBf16 { static constexpr bool F32 = false; const bf16_t* K; const bf16_t* V; long kp, vp;
    __device__ __forceinline__ const void* kptr(int pos, int e) const { return K + (size_t)pos * kp + e; }
    __device__ __forceinline__ const void* vptr(int pos, int e) const { return V + (size_t)pos * vp + e; } };
struct KVSample { static constexpr bool F32 = true; const float* ck; const float* cv; const float* nk; const float* nv;
    __device__ __forceinline__ const void* kptr(int pos, int e) const { return (pos < 2048 ? ck + (size_t)pos * 1024 : nk + (size_t)(pos - 2048) * 1024) + e; }
    __device__ __forceinline__ const void* vptr(int pos, int e) const { return (pos < 2048 ? cv + (size_t)pos * 1024 : nv + (size_t)(pos - 2048) * 1024) + e; } };
constexpr int VP = 272;

template <class KV, bool MASK, bool QNORM>
__device__ __forceinline__ void att_unit(const KV& kv, int nkb, int p0, int d, int pmax,
        const bf16_t* qbase, long qpitch, int nq, const float* qgain, const float* qssq, int qnp, float scale_log2,
        bf16_t* obase, long opitch, float* lsebase, long lsepitch, LAS unsigned char* vl, int lane) {
    const int qi = lane & 31, hf = lane >> 5;
    const int qic = qi < nq ? qi : nq - 1;
    const bf16_t* qrow = qbase + (size_t)qic * qpitch;
    bf16x8 qf[8];
#pragma unroll
    for (int s = 0; s < 8; ++s) qf[s] = *(const bf16x8*)(qrow + 16 * s + 8 * hf);
    if constexpr (QNORM) {
        float q1s = 0.f; for (int i = 0; i < qnp; ++i) q1s += qssq[qic * qnp + i];
        const float r1 = rsqrtf(q1s * (1.f / D) + EPS);
        float ss = 0.f;
#pragma unroll
        for (int s = 0; s < 8; ++s) { float f[8]; unpack8(__builtin_bit_cast(u32x4, qf[s]), f);
#pragma unroll
            for (int e = 0; e < 8; ++e) { const float t = f[e] * r1; ss += t * t; } }
        ss += __shfl_xor(ss, 32);
        const float r = rsqrtf(ss * (1.f / HD) + EPS) * r1;
#pragma unroll
        for (int s = 0; s < 8; ++s) { float f[8]; unpack8(__builtin_bit_cast(u32x4, qf[s]), f);
#pragma unroll
            for (int e = 0; e < 8; ++e) f[e] = f[e] * r * qgain[16 * s + 8 * hf + e];
            qf[s] = __builtin_bit_cast(bf16x8, pack8(f)); }
    }
    LAS unsigned char* ql = vl + 8 * 32 * VP + qi * VP + hf * 16;
#pragma unroll
    for (int s = 0; s < 8; ++s) *(LAS bf16x8*)(ql + s * 32) = qf[s];
    f32x16 o[4];
#pragma unroll
    for (int mb = 0; mb < 4; ++mb)
#pragma unroll
        for (int r = 0; r < 16; ++r) o[mb][r] = 0.f;
    float m = -1e30f, l = 0.f;
    constexpr bool PIPE = !KV::F32;
    bf16x8 kc[8], vc[8];
    const bf16_t* kp_ = nullptr; const bf16_t* vp_ = nullptr; long kstep_ = 0, vstep_ = 0, vj_ = 0;
    if constexpr (PIPE) {
        kp_ = (const bf16_t*)kv.kptr(0, 0) + (long)(p0 + d * qi) * kv.kp + 8 * hf; kstep_ = (long)32 * d * kv.kp;
        vp_ = (const bf16_t*)kv.vptr(0, 0) + (long)(p0 + d * (lane >> 4)) * kv.vp + (lane & 15) * 8; vstep_ = (long)32 * d * kv.vp; vj_ = (long)4 * d * kv.vp;
#pragma unroll
        for (int s = 0; s < 8; ++s) kc[s] = *(const bf16x8*)(kp_ + 16 * s);
#pragma unroll
        for (int j = 0; j < 8; ++j) vc[j] = *(const bf16x8*)(vp_ + j * vj_);
    }
    for (int kb = 0; kb < nkb; ++kb) {
        if constexpr (!PIPE) {   int pos = p0 + d * (kb * 32 + qi); pos = pos < 0 ? 0 : (pos > pmax ? pmax : pos);
#pragma unroll
            for (int s = 0; s < 8; ++s) kc[s] = ld8<KV::F32>(kv.kptr(pos, 16 * s + 8 * hf));
#pragma unroll
            for (int j = 0; j < 8; ++j) { const int id = lane + 64 * j; int pv = p0 + d * (kb * 32 + (id >> 4)); pv = pv < 0 ? 0 : (pv > pmax ? pmax : pv); vc[j] = ld8<KV::F32>(kv.vptr(pv, (id & 15) * 8)); } }
        f32x16 sacc;
#pragma unroll
        for (int r = 0; r < 16; ++r) sacc[r] = 0.f;
#pragma unroll
        for (int s = 0; s < 8; ++s) sacc = __builtin_amdgcn_mfma_f32_32x32x16_bf16(kc[s], *(const LAS bf16x8*)(ql + s * 32), sacc, 0, 0, 0);
        if (PIPE && kb + 1 < nkb) {
            kp_ += kstep_;
#pragma unroll
            for (int s = 0; s < 8; ++s) kc[s] = *(const bf16x8*)(kp_ + 16 * s);
        }
        if (MASK && (kb == 0 || kb == nkb - 1 || p0 + d * kb * 32 < 0)) {
#pragma unroll
            for (int r = 0; r < 16; ++r) { const int kk = kb * 32 + crow(r, hf); const int j = 128 + qi - kk; const bool ok = (j >= 0) && (j <= 128) && (p0 + d * kk >= 0); sacc[r] = ok ? sacc[r] : -INFINITY; }
        }
        float mx = sacc[0];
#pragma unroll
        for (int r = 1; r < 16; ++r) mx = fmaxf(mx, sacc[r]);
        mx = fmaxf(mx, __shfl_xor(mx, 32));
        const float mn = fmaxf(m, mx * scale_log2), alpha = __builtin_amdgcn_exp2f(m - mn); m = mn;
        float ls = 0.f;
#pragma unroll
        for (int r = 0; r < 16; ++r) { const float p = __builtin_amdgcn_exp2f(__builtin_fmaf(sacc[r], scale_log2, -mn)); ls += p; sacc[r] = p; }
        l = l * alpha + ls;
        if (__builtin_amdgcn_ballot_w64(alpha != 1.f) != 0ull) {
#pragma unroll
            for (int mb = 0; mb < 4; ++mb)
#pragma unroll
                for (int r = 0; r < 16; ++r) o[mb][r] *= alpha;
        }
        bf16x8 pf[2];
#pragma unroll
        for (int st = 0; st < 2; ++st) { u32x4 w; w.x = pk2(sacc[8 * st + 0], sacc[8 * st + 1]); w.y = pk2(sacc[8 * st + 2], sacc[8 * st + 3]); w.z = pk2(sacc[8 * st + 4], sacc[8 * st + 5]); w.w = pk2(sacc[8 * st + 6], sacc[8 * st + 7]);
            pf[st] = __builtin_bit_cast(bf16x8, w); }
#pragma unroll
        for (int j = 0; j < 8; ++j) { const int id = lane + 64 * j; *(LAS bf16x8*)(vl + (id >> 4) * VP + (id & 15) * 16) = vc[j]; }
        if (PIPE && kb + 1 < nkb) {
            vp_ += vstep_;
#pragma unroll
            for (int j = 0; j < 8; ++j) vc[j] = *(const bf16x8*)(vp_ + j * vj_);
        }
        LDS_WAIT();
        {
            const LAS unsigned char* trb = vl + (4 * hf + ((lane & 15) >> 2)) * VP + ((lane >> 4) & 1) * 32 + 8 * (lane & 3);
#pragma unroll
            for (int mb = 0; mb < 4; ++mb)
#pragma unroll
                for (int st = 0; st < 2; ++st) {
                    const s16x4 lo = __builtin_amdgcn_ds_read_tr16_b64_v4i16((LAS s16x4*)(trb + (16 * st) * VP + 64 * mb));
                    const s16x4 hi = __builtin_amdgcn_ds_read_tr16_b64_v4i16((LAS s16x4*)(trb + (16 * st + 8) * VP + 64 * mb));
                    const bf16x8 a = __builtin_shufflevector(lo, hi, 0, 1, 2, 3, 4, 5, 6, 7);
                    o[mb] = __builtin_amdgcn_mfma_f32_32x32x16_bf16(a, pf[st], o[mb], 0, 0, 0); } }
        LDS_WAIT();
    }
    l += __shfl_xor(l, 32);
    const float inv = 1.f / l;
    if (qi < nq) {
        bf16_t* orow = obase + (size_t)qi * opitch;
#pragma unroll
        for (int mb = 0; mb < 4; ++mb)
#pragma unroll
            for (int g4 = 0; g4 < 4; ++g4) { u32x2 w; w.x = pk2(o[mb][4 * g4] * inv, o[mb][4 * g4 + 1] * inv); w.y = pk2(o[mb][4 * g4 + 2] * inv, o[mb][4 * g4 + 3] * inv);
                *(u32x2*)(orow + 32 * mb + 8 * g4 + 4 * hf) = w; }
        if (lsebase && hf == 0) lsebase[(size_t)qi * lsepitch] = m * 0.6931471805599453f + logf(l);
    }
}

template <int W>
__device__ __forceinline__ void pool_strip(const bf16_t* proj, bf16_t* diff, int r0, int c0) {
    u32x4 raw[W + 7];
#pragma unroll
    for (int i = 0; i < W + 7; ++i) { const int t = r0 - (W - 1) + i; raw[i] = (u32x4){0u, 0u, 0u, 0u}; if (t >= 0) raw[i] = *(const u32x4*)(proj + (size_t)t * INW + c0); }
    float s[8];
#pragma unroll
    for (int e = 0; e < 8; ++e) s[e] = 0.f;
#pragma unroll
    for (int i = 0; i < W - 1; ++i) { float f[8]; unpack8(raw[i], f);
#pragma unroll
        for (int e = 0; e < 8; ++e) s[e] += f[e]; }
#pragma unroll
    for (int i = 0; i < 8; ++i) { float f[8], fo[8], dv[8]; unpack8(raw[W - 1 + i], f); unpack8(raw[i], fo);
        const int row = r0 + i; const float inv = 1.f / (float)(row + 1 < W ? row + 1 : W);
#pragma unroll
        for (int e = 0; e < 8; ++e) { s[e] += f[e]; dv[e] = s[e] * inv - f[e]; s[e] -= fo[e]; }
        *(u32x4*)(diff + (size_t)row * 1024 + c0) = pack8(dv); }
}
__device__ __forceinline__ void mem_att_unit_lds(const LAS unsigned char* kl, const LAS unsigned char* vl2, const bf16_t* qbase, const float* qgain, const float* qssq, int qnp, int nq, float scale_log2, bf16_t* obase, int lane) {
    const int qi = lane & 31, hf = lane >> 5, qic = qi < nq ? qi : nq - 1;
    const bf16_t* qrow = qbase + (size_t)qic * MEMW;
    bf16x8 qf[8];
#pragma unroll
    for (int s = 0; s < 8; ++s) qf[s] = *(const bf16x8*)(qrow + 16 * s + 8 * hf);
    {   float q1s = 0.f; for (int i = 0; i < qnp; ++i) q1s += qssq[qic * qnp + i];
        const float r1 = rsqrtf(q1s * (1.f / D) + EPS);
        float ss = 0.f;
#pragma unroll
        for (int s = 0; s < 8; ++s) { float f[8]; unpack8(__builtin_bit_cast(u32x4, qf[s]), f);
#pragma unroll
            for (int e = 0; e < 8; ++e) { const float t = f[e] * r1; ss += t * t; } }
        ss += __shfl_xor(ss, 32);
        const float r = rsqrtf(ss * (1.f / HD) + EPS) * r1;
#pragma unroll
        for (int s = 0; s < 8; ++s) { float f[8]; unpack8(__builtin_bit_cast(u32x4, qf[s]), f);
#pragma unroll
            for (int e = 0; e < 8; ++e) f[e] = f[e] * r * qgain[16 * s + 8 * hf + e];
            qf[s] = __builtin_bit_cast(bf16x8, pack8(f)); } }
    f32x16 o[4];
#pragma unroll
    for (int mb = 0; mb < 4; ++mb)
#pragma unroll
        for (int r = 0; r < 16; ++r) o[mb][r] = 0.f;
    float m = -1e30f, l = 0.f;
    const LAS unsigned char* kp = kl + qi * VP + hf * 16;
    const LAS unsigned char* trb = vl2 + (4 * hf + ((lane & 15) >> 2)) * VP + ((lane >> 4) & 1) * 32 + 8 * (lane & 3);
#pragma unroll 2
    for (int kb = 0; kb < 8; ++kb) {
        f32x16 sacc;
#pragma unroll
        for (int r = 0; r < 16; ++r) sacc[r] = 0.f;
#pragma unroll
        for (int s = 0; s < 8; ++s) sacc = __builtin_amdgcn_mfma_f32_32x32x16_bf16(*(const LAS bf16x8*)(kp + kb * 32 * VP + s * 32), qf[s], sacc, 0, 0, 0);
        float mx = sacc[0];
#pragma unroll
        for (int r = 1; r < 16; ++r) mx = fmaxf(mx, sacc[r]);
        mx = fmaxf(mx, __shfl_xor(mx, 32));
        const float mn = fmaxf(m, mx * scale_log2), alpha = __builtin_amdgcn_exp2f(m - mn); m = mn;
        float ls = 0.f;
#pragma unroll
        for (int r = 0; r < 16; ++r) { const float p = __builtin_amdgcn_exp2f(__builtin_fmaf(sacc[r], scale_log2, -mn)); ls += p; sacc[r] = p; }
        l = l * alpha + ls;
        if (__builtin_amdgcn_ballot_w64(alpha != 1.f) != 0ull) {
#pragma unroll
            for (int mb = 0; mb < 4; ++mb)
#pragma unroll
                for (int r = 0; r < 16; ++r) o[mb][r] *= alpha;
        }
        bf16x8 pf[2];
#pragma unroll
        for (int st = 0; st < 2; ++st) { u32x4 w; w.x = pk2(sacc[8 * st + 0], sacc[8 * st + 1]); w.y = pk2(sacc[8 * st + 2], sacc[8 * st + 3]); w.z = pk2(sacc[8 * st + 4], sacc[8 * st + 5]); w.w = pk2(sacc[8 * st + 6], sacc[8 * st + 7]);
            pf[st] = __builtin_bit_cast(bf16x8, w); }
#pragma unroll
        for (int mb = 0; mb < 4; ++mb)
#pragma unroll
            for (int st = 0; st < 2; ++st) {
                const s16x4 lo = __builtin_amdgcn_ds_read_tr16_b64_v4i16((LAS s16x4*)(trb + (kb * 32 + 16 * st) * VP + 64 * mb));
                const s16x4 hi = __builtin_amdgcn_ds_read_tr16_b64_v4i16((LAS s16x4*)(trb + (kb * 32 + 16 * st + 8) * VP + 64 * mb));
                const bf16x8 a = __builtin_shufflevector(lo, hi, 0, 1, 2, 3, 4, 5, 6, 7);
                o[mb] = __builtin_amdgcn_mfma_f32_32x32x16_bf16(a, pf[st], o[mb], 0, 0, 0); }
    }
    l += __shfl_xor(l, 32);
    const float inv = 1.f / l;
    if (qi < nq) { bf16_t* orow = obase + (size_t)qi * MEMW;
#pragma unroll
    for (int mb = 0; mb < 4; ++mb)
#pragma unroll
        for (int g4 = 0; g4 < 4; ++g4) { u32x2 w; w.x = pk2(o[mb][4 * g4] * inv, o[mb][4 * g4 + 1] * inv); w.y = pk2(o[mb][4 * g4 + 2] * inv, o[mb][4 * g4 + 3] * inv);
            *(u32x2*)(orow + 32 * mb + 8 * g4 + 4 * hf) = w; } }
}

typedef __attribute__((address_space(4))) const Args CArgs;
__device__ __forceinline__ CArgs* phase_args() { CArgs* p = (CArgs*)__builtin_amdgcn_kernarg_segment_ptr(); asm volatile("" : "+s"(p)); return p; }
constexpr int NPH = 14;
__global__ void __launch_bounds__(512, 2) mega_fwd(Args args) {
    extern __shared__ __attribute__((aligned(16))) unsigned char lds_raw[];
    LAS unsigned char* lds = (LAS unsigned char*)lds_raw;
    const int tid = threadIdx.x, lane = tid & 63, wave = __builtin_amdgcn_readfirstlane(tid >> 6);
    const int G = gridDim.x, bx = blockIdx.x;
    const int gw = bx * 8 + wave, NGW = G * 8;
    const int gt = bx * 512 + tid, NGT = G * 512;
#define out (pa->out)
#define WSP (pa->ws)
#define x_prompt (pa->in[0])
#define x_sample (pa->in[1])
#define state_pool (pa->in[2])
#define cache_win_k (pa->in[3])
#define cache_win_v (pa->in[4])
#define cache_mem_k (pa->in[5])
#define cache_mem_v (pa->in[6])
#define state_conv (pa->in[7])
#define mem_prompt (pa->in[8])
#define norm_mix (pa->in[9])
#define w_in (pa->in[10])
#define q_norm (pa->in[11])
#define k_norm (pa->in[12])
#define w_pool (pa->in[13])
#define pool_scale (pa->in[14])
#define w_out (pa->in[15])
#define norm_mem (pa->in[16])
#define norm_mem_src (pa->in[17])
#define w_mem_q (pa->in[18])
#define w_mem_k (pa->in[19])
#define w_mem_v (pa->in[20])
#define mem_q_norm (pa->in[21])
#define mem_k_norm (pa->in[22])
#define w_mem_o (pa->in[23])
#define norm_ffn (pa->in[24])
#define w_gate (pa->in[25])
#define w_up (pa->in[26])
#define conv_w (pa->in[27])
#define conv_b (pa->in[28])
#define w_down (pa->in[29])
#define WT_IN ((bf16_t*)(WSP + WS_WIN))
#define WT_OUT ((bf16_t*)(WSP + WS_WOUT))
#define WT_MQ ((bf16_t*)(WSP + WS_WMQ))
#define WT_MKV ((bf16_t*)(WSP + WS_WMKV))
#define WT_MO ((bf16_t*)(WSP + WS_WMO))
#define WT_GU ((bf16_t*)(WSP + WS_WGU))
#define WT_DN ((bf16_t*)(WSP + WS_WDN))
#define WT_POOL ((bf16_t*)(WSP + WS_WPOOL))
#define MK ((bf16_t*)(WSP + WS_MK))
#define MV ((bf16_t*)(WSP + WS_MV))
#define MN ((bf16_t*)(WSP + WS_MN))
#define MEMKV ((float*)(WSP + WS_MEMKV))
#define CMK ((bf16_t*)(WSP + WS_CMK))
#define CMV ((bf16_t*)(WSP + WS_CMV))
#define LSE ((float*)(WSP + WS_LSE))
#define H ((bf16_t*)(WSP + WS_H))
#define XRES ((float*)(WSP + WS_XRES))
#define QM ((bf16_t*)(WSP + WS_QM))
#define OM ((bf16_t*)(WSP + WS_OM))
#define PROJ ((bf16_t*)(WSP + WS_PROJ))
#define QN ((bf16_t*)(WSP + WS_QN))
#define KN ((bf16_t*)(WSP + WS_KN))
#define DIFF ((bf16_t*)(WSP + WS_DIFF))
#define MIXED ((bf16_t*)(WSP + WS_MIXED))
#define OP ((bf16_t*)(WSP + WS_OP))
#define PSSQ1 ((float*)(WSP))
#define PSSQ2 ((float*)(WSP + 512 * 1024))
#define SSQ1 ((float*)(WSP + WS_SSQ1))
#define SSQ2 ((float*)(WSP + WS_SSQ2))
#define FIRSTG ((float*)(WSP + WS_FG))
#define FIRSTUP ((float*)(WSP + WS_FU))
#define LASTG ((float*)(WSP + WS_LG))
#define GB ((bf16_t*)(WSP + WS_G))
#define UPB ((bf16_t*)(WSP + WS_UP))
    volatile LAS unsigned* bst = (volatile LAS unsigned*)(lds + LDS_BYTES - 16);
    if (tid == 0) { bst[0] = 0u; bst[1] = 0u; }
    __syncthreads();
    XcdBarrier gbar = xcd_barrier_post((unsigned*)(args.ws + WS_BAR), bst);
    const int lo = args.ph_lo, hi = args.ph_hi;
#define IN(k) ((((PHMASK) >> (k)) & 1) && lo <= (k) && (k) < hi)
#define SEAM(k) do { if (args.coop == 2) cg::this_grid().sync(); else if (args.coop) xcd_barrier(gbar); } while (0)
    constexpr float SCALE_LOG2 = 0.08838834764831845f * 1.4426950408889634f;

    if (IN(0)) { CArgs* pa = phase_args();
        LAS float* scr = (LAS float*)(lds + wave * 17408);
        constexpr int I_IN = 32 * 64, I_OUT = 32 * 32, I_MQ = 32 * 8, I_MO = 8 * 32, I_G = 32 * 88, I_DN = 88 * 32, I_PL = 4 * 4;
        constexpr int NIT = I_IN + I_OUT + 3 * I_MQ + I_MO + 4 * I_PL;
        for (int it = gw; it < NIT; it += NGW) {
            int r = it;
            if (r < I_IN) { transpose_mat(w_in, D, INW, WT_IN, 0, 0, nullptr, nullptr, r, scr, lane); continue; } r -= I_IN;
            if (r < I_OUT) { transpose_mat(w_out, D, D, WT_OUT, 0, 0, nullptr, nullptr, r, scr, lane); continue; } r -= I_OUT;
            if (r < I_MQ) { transpose_mat(w_mem_q, D, MEMW, WT_MQ, 0, 0, nullptr, norm_mem, r, scr, lane); continue; } r -= I_MQ;
            if (r < I_MQ) { transpose_mat(w_mem_k, D, MEMW, WT_MKV, 0, 0, nullptr, nullptr, r, scr, lane); continue; } r -= I_MQ;
            if (r < I_MQ) { transpose_mat(w_mem_v, D, MEMW, WT_MKV, 0, 512, nullptr, nullptr, r, scr, lane); continue; } r -= I_MQ;
            if (r < I_MO) { transpose_mat(w_mem_o, MEMW, D, WT_MO, 0, 0, nullptr, nullptr, r, scr, lane); continue; } r -= I_MO;
            { const int g = r / I_PL; transpose_mat(w_pool + (size_t)g * 65536, 256, 256, WT_POOL, 0, g * 256, pool_scale, nullptr, r % I_PL, scr, lane); }
        }
        for (int idx = gt; idx < 65536; idx += NGT) SSQ1[idx] = 0.f;
        {
#define P0_SRC(m_) ((m_) < T ? x_prompt + (size_t)(m_) * D : ((m_) < MR ? x_sample + (size_t)((m_) - T) * D : mem_prompt + (size_t)((m_) - MR) * D))
            f32x4 v[8], nv[8];
            int m = gw;
            if (m < MR + NMEM) { const float* xs = P0_SRC(m);
#pragma unroll
                for (int j = 0; j < 8; ++j) v[j] = ((const f32x4*)xs)[lane + 64 * j]; }
            for (; m < MR + NMEM; m += NGW) {
                const int nm = m + NGW;
#pragma unroll
                for (int j = 0; j < 8; ++j) nv[j] = v[j];
                if (nm < MR + NMEM) { const float* xs = P0_SRC(nm);
#pragma unroll
                    for (int j = 0; j < 8; ++j) nv[j] = ((const f32x4*)xs)[lane + 64 * j]; }
                const float* gain = m < MR ? norm_mix : norm_mem_src; bf16_t* o = m < MR ? H + (size_t)m * D : MN + (size_t)(m - MR) * D;
                float ssum = 0.f;
#pragma unroll
                for (int j = 0; j < 8; ++j) ssum += (v[j].x * v[j].x + v[j].y * v[j].y) + (v[j].z * v[j].z + v[j].w * v[j].w);
                const float r = rsqrtf(wave_sum(ssum) * (1.f / D) + EPS);
#pragma unroll
                for (int j = 0; j < 8; ++j) { const f32x4 gn = ((const f32x4*)gain)[lane + 64 * j]; u32x2 w; w.x = pk2(v[j].x * r * gn.x, v[j].y * r * gn.y); w.y = pk2(v[j].z * r * gn.z, v[j].w * r * gn.w);
                    ((u32x2*)o)[lane + 64 * j] = w; }
#pragma unroll
                for (int j = 0; j < 8; ++j) v[j] = nv[j];
            }
#undef P0_SRC
        }
        __syncthreads();
    }
    SEAM(0);
    if (IN(1)) { CArgs* pa = phase_args();
        skinny_gemm(lds, H + (size_t)T * D, D, WT_IN, D, D, INW / 16, 1, bx, G, wave, lane, tid, SkBf16{PROJ + (size_t)T * INW, INW});
        skinny_gemm<4>(lds, MN, D, WT_MKV, D, D, 1024 / 16, 2, bx, G, wave, lane, tid, SkF32{MEMKV, 1024});
        { pg8::Gemm g{H, WT_IN, D, D, D, 0}; pg8::StaticOrder S; S.init(T, INW, G, bx); pg8::EpiBf16 E{PROJ, INW}; pg8::gemm_phase(lds, g, S, E); }
    }
    SEAM(1);
    if (IN(2)) { CArgs* pa = phase_args();
        {
            const int sub = lane & 15, hq = lane >> 4;
#define P2_LOAD(dst, row_) do { const bf16_t* pr_ = PROJ + (size_t)(row_) * INW + 1024 + hq * 128 + sub * 4; _Pragma("unroll") for (int p_ = 0; p_ < 4; ++p_) { dst[2 * p_] = *(const u32x2*)(pr_ + p_ * 512); dst[2 * p_ + 1] = *(const u32x2*)(pr_ + p_ * 512 + 64); } } while (0)
            u32x2 ra[8], rn[8];
            int row = gw;
            if (row < MR) P2_LOAD(ra, row);
            for (; row < MR; row += NGW) {
                const int nrow = row + NGW;
#pragma unroll
                for (int i = 0; i < 8; ++i) rn[i] = ra[i];
                if (nrow < MR) P2_LOAD(rn, nrow);
                const int pos = row < T ? row : T + ((row - T) & 3);
                float cs[4], sn[4];
#pragma unroll
                for (int e = 0; e < 4; ++e) { const double t = (double)pos * INVF[sub * 4 + e] * 0.15915494309189535; const float fr = (float)(t - rint(t));
                    cs[e] = __builtin_amdgcn_cosf(fr); sn[e] = __builtin_amdgcn_sinf(fr); }
                const bf16_t* pr = PROJ + (size_t)row * INW;
#pragma unroll
                for (int p = 0; p < 4; ++p) { const int hh = p * 4 + hq;
                    const u32x2 a1 = ra[2 * p], a2 = ra[2 * p + 1];
                    float x1[4] = {bf2f(a1.x & 0xffffu), bf2f(a1.x >> 16), bf2f(a1.y & 0xffffu), bf2f(a1.y >> 16)};
                    float x2[4] = {bf2f(a2.x & 0xffffu), bf2f(a2.x >> 16), bf2f(a2.y & 0xffffu), bf2f(a2.y >> 16)};
                    float ss = (x1[0] * x1[0] + x1[1] * x1[1]) + (x1[2] * x1[2] + x1[3] * x1[3]) + (x2[0] * x2[0] + x2[1] * x2[1]) + (x2[2] * x2[2] + x2[3] * x2[3]);
                    ss += __shfl_xor(ss, 1); ss += __shfl_xor(ss, 2); ss += __shfl_xor(ss, 4); ss += __shfl_xor(ss, 8);
                    const float rstd = rsqrtf(ss * (1.f / HD) + EPS);
                    const float* gp = hh < 8 ? q_norm : k_norm; const f32x4 g1 = *(const f32x4*)(gp + sub * 4), g2 = *(const f32x4*)(gp + 64 + sub * 4);
                    float o1[4], o2[4];
#pragma unroll
                    for (int e = 0; e < 4; ++e) { const float y1 = x1[e] * rstd * g1[e], y2 = x2[e] * rstd * g2[e]; o1[e] = y1 * cs[e] - y2 * sn[e]; o2[e] = y1 * sn[e] + y2 * cs[e]; }
                    bf16_t* dst = (hh < 8 ? QN : KN) + (size_t)row * 1024 + (hh & 7) * 128 + sub * 4;
                    u32x2 w1, w2; w1.x = pk2(o1[0], o1[1]); w1.y = pk2(o1[2], o1[3]); w2.x = pk2(o2[0], o2[1]); w2.y = pk2(o2[2], o2[3]);
                    *(u32x2*)dst = w1; *(u32x2*)(dst + 64) = w2;
                    if (hh >= 8 && row >= T - 2048) { float* ko = (row < T ? out + O_PWK + (size_t)(row - (T - 2048)) * 1024 : out + O_SWK + (size_t)(row - T) * 1024) + (hh - 8) * 128 + sub * 4;
                        *(f32x4*)ko = (f32x4){o1[0], o1[1], o1[2], o1[3]}; *(f32x4*)(ko + 64) = (f32x4){o2[0], o2[1], o2[2], o2[3]}; } }
                if (row >= T - 2048) { float* vo = row < T ? out + O_PWV + (size_t)(row - (T - 2048)) * 1024 : out + O_SWV + (size_t)(row - T) * 1024;
#pragma unroll
                    for (int j = 0; j < 2; ++j) { float f[8]; unpack8(*(const u32x4*)(pr + 3072 + lane * 8 + 512 * j), f);
                        *(f32x4*)(vo + lane * 8 + 512 * j) = (f32x4){f[0], f[1], f[2], f[3]}; *(f32x4*)(vo + lane * 8 + 512 * j + 4) = (f32x4){f[4], f[5], f[6], f[7]}; } }
#pragma unroll
                for (int i = 0; i < 8; ++i) ra[i] = rn[i];
            }
#undef P2_LOAD
        }
        for (int it = gw; it < 4 * (T / 16); it += NGW) {
            const int g = it & 3, sp = it >> 2, r0 = (2 * sp + (lane >> 5)) * 8, c0 = g * 256 + (lane & 31) * 8;
            if (g == 0) pool_strip<2>(PROJ, DIFF, r0, c0); else if (g == 1) pool_strip<4>(PROJ, DIFF, r0, c0); else if (g == 2) pool_strip<8>(PROJ, DIFF, r0, c0); else pool_strip<16>(PROJ, DIFF, r0, c0);
        }
        for (int it = gw; it < 4 * (NS / 2); it += NGW) {
            const int g = it & 3, rp = it >> 2, row = T + 2 * rp + (lane >> 5), c0 = g * 256 + (lane & 31) * 8, w = 2 << g;
            float acc[8], cur[8];
#pragma unroll
            for (int e = 0; e < 8; ++e) { acc[e] = 0.f; cur[e] = 0.f; }
            const int b = (row - T) >> 2, tq = (row - T) & 3;
            for (int j = 0; j < w; ++j) { const int e15 = 15 + tq - j; float f[8];
                if (e15 >= 15) unpack8(*(const u32x4*)(PROJ + (size_t)(T + b * 4 + e15 - 15) * INW + c0), f);
                else { const float* sp = state_pool + ((size_t)b * 15 + e15) * 1024 + c0; const f32x4 a = *(const f32x4*)sp, bb = *(const f32x4*)(sp + 4);
                    f[0] = a.x; f[1] = a.y; f[2] = a.z; f[3] = a.w; f[4] = bb.x; f[5] = bb.y; f[6] = bb.z; f[7] = bb.w; }
#pragma unroll
                for (int e = 0; e < 8; ++e) { acc[e] += f[e]; if (j == 0) cur[e] = f[e]; } }
            float dv[8];
#pragma unroll
            for (int e = 0; e < 8; ++e) dv[e] = acc[e] / (float)w - cur[e];
            *(u32x4*)(DIFF + (size_t)row * 1024 + c0) = pack8(dv);
        }
        for (int idx = gt; idx < 15 * 1024 + 32 * 15 * 1024; idx += NGT) {
            if (idx < 15 * 1024) { const int e = idx >> 10, c = idx & 1023; out[O_PSP + idx] = bf2f(PROJ[(size_t)(T - 15 + e) * INW + c]); }
            else { const int j = idx - 15 * 1024, b = j / (15 * 1024), e = (j >> 10) % 15, c = j & 1023;
                out[O_SSP + j] = (e + 4 < 15) ? state_pool[((size_t)b * 15 + e + 4) * 1024 + c] : bf2f(PROJ[(size_t)(T + b * 4 + e + 4 - 15) * INW + c]); }
        }
        for (int row = gw; row < NMEM; row += NGW) {
            const float* kp = MEMKV + (size_t)row * 1024 + lane * 8; const f32x4 a = *(const f32x4*)kp, b = *(const f32x4*)(kp + 4);
            float f[8] = {a.x, a.y, a.z, a.w, b.x, b.y, b.z, b.w}; float ss = 0.f;
#pragma unroll
            for (int e = 0; e < 8; ++e) ss += f[e] * f[e];
            ss += __shfl_xor(ss, 1); ss += __shfl_xor(ss, 2); ss += __shfl_xor(ss, 4); ss += __shfl_xor(ss, 8);
            const float rstd = rsqrtf(ss * (1.f / HD) + EPS);
#pragma unroll
            for (int e = 0; e < 8; ++e) f[e] = f[e] * rstd * mem_k_norm[(lane & 15) * 8 + e];
            float* ko = out + O_PMK + (size_t)row * 512 + lane * 8; *(f32x4*)ko = (f32x4){f[0], f[1], f[2], f[3]}; *(f32x4*)(ko + 4) = (f32x4){f[4], f[5], f[6], f[7]};
            *(u32x4*)(MK + (size_t)row * 512 + lane * 8) = pack8(f);
            const float* vp = kp + 512; const f32x4 c = *(const f32x4*)vp, dd = *(const f32x4*)(vp + 4);
            float* vo = out + O_PMV + (size_t)row * 512 + lane * 8; *(f32x4*)vo = c; *(f32x4*)(vo + 4) = dd;
            float fv[8] = {c.x, c.y, c.z, c.w, dd.x, dd.y, dd.z, dd.w}; *(u32x4*)(MV + (size_t)row * 512 + lane * 8) = pack8(fv);
        }
    }
    SEAM(2);
    if (IN(3)) { CArgs* pa = phase_args();
        { pg8::Gemm g{DIFF, WT_POOL, 1024, 256, 256, 512}; pg8::StaticOrder S; S.init(MP, 1024, G, bx); pg8::EpiBf16 E{MIXED, D}; pg8::gemm_phase(lds, g, S, E); }
        __syncthreads();
        {   LAS unsigned char* vl = lds + wave * (32 * VP);
            constexpr int NU_S = 32 * 72;
            for (int u = gw; u < NU_S; u += NGW) {
                const int b = u / 72, rem = u % 72, h = rem / 9, kind = rem % 9;
                const int g = kind == 0 ? 0 : (kind < 5 ? 1 : 2), d = kind == 0 ? 1 : (kind < 5 ? 4 : 16), tq0 = kind == 0 ? 0 : (kind < 5 ? kind - 1 : kind - 5), nq = kind == 0 ? 4 : 1;
                KVSample kv{cache_win_k + ((size_t)b * 2048) * 1024 + h * 128, cache_win_v + ((size_t)b * 2048) * 1024 + h * 128,
                            out + O_SWK + ((size_t)b * 4) * 1024 + h * 128, out + O_SWV + ((size_t)b * 4) * 1024 + h * 128};
                const size_t qr = (size_t)(T + b * 4 + tq0);
                att_unit<KVSample, true, false>(kv, 5, 2048 + tq0 - 128 * d, d, 2048 + tq0 + nq - 1, QN + qr * 1024 + h * 128, 1024, nq, nullptr, nullptr, 0, SCALE_LOG2,
                                                OP + ((size_t)g * MP + qr) * 1024 + h * 128, 1024, LSE + ((size_t)g * MP + qr) * 8 + h, 8, vl, lane);
            }
            __syncthreads(); }
        {   LAS unsigned char* kl = lds; LAS unsigned char* vl2 = lds + 256 * VP;
            constexpr int NGRP = 3 * 8 * 128;
            bf16x8 pk[8], pv[8];
#define DG_DECODE(gid_) const int g_ = (gid_) >> 10, h_ = ((gid_) >> 7) & 7, w_ = (gid_) & 127, d_ = g_ == 0 ? 1 : (g_ == 1 ? 4 : 16), ng_ = 128 / d_, r_ = w_ / ng_, i0_ = (w_ % ng_) * 128
#define DG_LOAD(gid_) do { DG_DECODE(gid_); _Pragma("unroll") for (int j = 0; j < 8; ++j) { const int key = (tid >> 4) + 32 * j, chk = tid & 15; const int pos = r_ + d_ * (i0_ - 128 + key); \
        pk[j] = (bf16x8){0, 0, 0, 0, 0, 0, 0, 0}; pv[j] = pk[j]; if (pos >= 0) { pk[j] = *(const bf16x8*)(KN + (size_t)pos * 1024 + h_ * 128 + chk * 8); pv[j] = *(const bf16x8*)(PROJ + (size_t)pos * INW + 3072 + h_ * 128 + chk * 8); } } } while (0)
            const bool bal = (G == 256);
            const int vj = (bx & 7) * 28 + ((bx >> 3) - 4);
            int gid = bal ? (bx < 32 ? bx * 4 : 128 + vj) : bx;
            const int gstep = bal ? (bx < 32 ? 1 : 224) : G, gend = bal && bx < 32 ? bx * 4 + 4 : NGRP;
            bf16x8 qf[8];
#define DG_QLOAD(gid_) do { const int g2 = (gid_) >> 10, h2 = ((gid_) >> 7) & 7, w2 = (gid_) & 127, d2 = g2 == 0 ? 1 : (g2 == 1 ? 4 : 16), n2 = 128 / d2, r2 = w2 / n2, i2 = (w2 % n2) * 128; \
        const int tq2 = r2 + d2 * (i2 + 32 * (wave & 3) + (lane & 31)); _Pragma("unroll") for (int s2 = 0; s2 < 8; ++s2) qf[s2] = *(const bf16x8*)(QN + (size_t)tq2 * 1024 + h2 * 128 + 16 * s2 + 8 * (lane >> 5)); } while (0)
            if (gid < gend) { DG_LOAD(gid); DG_QLOAD(gid); }
            for (; gid < gend; gid += gstep) {
#pragma unroll
                for (int j = 0; j < 8; ++j) { const int key = (tid >> 4) + 32 * j, chk = tid & 15; *(LAS bf16x8*)(kl + key * VP + chk * 16) = pk[j]; *(LAS bf16x8*)(vl2 + key * VP + chk * 16) = pv[j]; }
                __syncthreads();
                if (gid + gstep < gend) DG_LOAD(gid + gstep);
                DG_DECODE(gid);
                const int ju = wave & 3, half = wave >> 2, qi = lane & 31, hf = lane >> 5;
                const int tq = r_ + d_ * (i0_ + 32 * ju + qi);
                const int pu0 = r_ + d_ * (i0_ + 32 * ju - 128);
                f32x16 o[4];
#pragma unroll
                for (int mb = 0; mb < 4; ++mb)
#pragma unroll
                    for (int r = 0; r < 16; ++r) o[mb][r] = 0.f;
                float m = -1e30f, l = 0.f;
                const LAS unsigned char* kp = kl + (32 * ju + qi) * VP + hf * 16;
                const LAS unsigned char* trb = vl2 + (32 * ju + 4 * hf + ((lane & 15) >> 2)) * VP + ((lane >> 4) & 1) * 32 + 8 * (lane & 3);
                const int kb0 = half ? 3 : 0, kb1 = half ? 5 : 3;
                for (int kb = kb0; kb < kb1; ++kb) {
                    f32x16 sacc;
#pragma unroll
                    for (int r = 0; r < 16; ++r) sacc[r] = 0.f;
#pragma unroll
                    for (int s2 = 0; s2 < 8; ++s2) sacc = __builtin_amdgcn_mfma_f32_32x32x16_bf16(*(const LAS bf16x8*)(kp + kb * 32 * VP + s2 * 32), qf[s2], sacc, 0, 0, 0);
                    if (kb == 0 || kb == 4 || pu0 + d_ * kb * 32 < 0) {
#pragma unroll
                        for (int r = 0; r < 16; ++r) { const int kk = kb * 32 + crow(r, hf); const int jj = 128 + qi - kk; const bool ok = (jj >= 0) && (jj <= 128) && (pu0 + d_ * kk >= 0); sacc[r] = ok ? sacc[r] : -INFINITY; }
                    }
                    float mx = sacc[0];
#pragma unroll
                    for (int r = 1; r < 16; ++r) mx = fmaxf(mx, sacc[r]);
                    mx = fmaxf(mx, __shfl_xor(mx, 32));
                    const float mn = fmaxf(m, mx * SCALE_LOG2), alpha = __builtin_amdgcn_exp2f(m - mn); m = mn;
                    float ls = 0.f;
#pragma unroll
                    for (int r = 0; r < 16; ++r) { const float p = __builtin_amdgcn_exp2f(__builtin_fmaf(sacc[r], SCALE_LOG2, -mn)); ls += p; sacc[r] = p; }
                    l = l * alpha + ls;
                    if (__builtin_amdgcn_ballot_w64(alpha != 1.f) != 0ull) {
#pragma unroll
                        for (int mb = 0; mb < 4; ++mb)
#pragma unroll
                            for (int r = 0; r < 16; ++r) o[mb][r] *= alpha;
                    }
                    bf16x8 pf[2];
#pragma unroll
                    for (int st = 0; st < 2; ++st) { u32x4 w; w.x = pk2(sacc[8 * st + 0], sacc[8 * st + 1]); w.y = pk2(sacc[8 * st + 2], sacc[8 * st + 3]); w.z = pk2(sacc[8 * st + 4], sacc[8 * st + 5]); w.w = pk2(sacc[8 * st + 6], sacc[8 * st + 7]);
                        pf[st] = __builtin_bit_cast(bf16x8, w); }
#pragma unroll
                    for (int mb = 0; mb < 4; ++mb)
#pragma unroll
                        for (int st = 0; st < 2; ++st) {
                            const s16x4 lo = __builtin_amdgcn_ds_read_tr16_b64_v4i16((LAS s16x4*)(trb + (kb * 32 + 16 * st) * VP + 64 * mb));
                            const s16x4 hi = __builtin_amdgcn_ds_read_tr16_b64_v4i16((LAS s16x4*)(trb + (kb * 32 + 16 * st + 8) * VP + 64 * mb));
                            const bf16x8 a = __builtin_shufflevector(lo, hi, 0, 1, 2, 3, 4, 5, 6, 7);
                            o[mb] = __builtin_amdgcn_mfma_f32_32x32x16_bf16(a, pf[st], o[mb], 0, 0, 0); }
                }
                l += __shfl_xor(l, 32);
                if (gid + gstep < gend) DG_QLOAD(gid + gstep);
                __syncthreads();
                LAS float* part = (LAS float*)(kl + ju * 17408);
                if (half) {
#pragma unroll
                    for (int mb = 0; mb < 4; ++mb)
#pragma unroll
                        for (int r = 0; r < 16; ++r) part[(mb * 16 + r) * 64 + lane] = o[mb][r];
                    part[64 * 64 + lane] = m; part[65 * 64 + lane] = l;
                }
                __syncthreads();
                if (!half) {
                    const float mB = part[64 * 64 + lane], lB = part[65 * 64 + lane];
                    const float mt = fmaxf(m, mB), aA = __builtin_amdgcn_exp2f(m - mt), aB = __builtin_amdgcn_exp2f(mB - mt);
                    const float lt = l * aA + lB * aB, inv = 1.f / lt;
                    bf16_t* orow = OP + ((size_t)g_ * MP + tq) * 1024 + h_ * 128;
#pragma unroll
                    for (int mb = 0; mb < 4; ++mb)
#pragma unroll
                        for (int g4 = 0; g4 < 4; ++g4) { float v4[4];
#pragma unroll
                            for (int e = 0; e < 4; ++e) v4[e] = (o[mb][4 * g4 + e] * aA + part[(mb * 16 + 4 * g4 + e) * 64 + lane] * aB) * inv;
                            u32x2 w; w.x = pk2(v4[0], v4[1]); w.y = pk2(v4[2], v4[3]); *(u32x2*)(orow + 32 * mb + 8 * g4 + 4 * hf) = w; }
                    if (hf == 0) LSE[((size_t)g_ * MP + tq) * 8 + h_] = mt * 0.6931471805599453f + logf(lt);
                }
                __syncthreads();
            }
#undef DG_LOAD
#undef DG_QLOAD
#undef DG_DECODE
        }
    }
    SEAM(3);
    if (IN(4)) { CArgs* pa = phase_args();
        for (int idx0 = gt; idx0 < MR * 128; idx0 += 2 * NGT) {
            u32x4 ra[2][3]; float lw[2][3];
#pragma unroll
            for (int q = 0; q < 2; ++q) { const int idx = idx0 + q * NGT; if (idx < MR * 128) { const int row = idx >> 7, ch = idx & 127, h = ch >> 4;
#pragma unroll
                for (int g = 0; g < 3; ++g) { lw[q][g] = LSE[((size_t)g * MP + row) * 8 + h]; ra[q][g] = *(const u32x4*)(OP + ((size_t)g * MP + row) * 1024 + ch * 8); } } }
#pragma unroll
            for (int q = 0; q < 2; ++q) { const int idx = idx0 + q * NGT; if (idx < MR * 128) { const int row = idx >> 7, ch = idx & 127;
                const float mx = fmaxf(lw[q][0], fmaxf(lw[q][1], lw[q][2])); float w0 = __expf(lw[q][0] - mx), w1 = __expf(lw[q][1] - mx), w2 = __expf(lw[q][2] - mx); const float iz = 1.f / (w0 + w1 + w2); w0 *= iz; w1 *= iz; w2 *= iz;
                float a[8], b[8], c[8], o[8]; unpack8(ra[q][0], a); unpack8(ra[q][1], b); unpack8(ra[q][2], c);
#pragma unroll
                for (int e = 0; e < 8; ++e) o[e] = w0 * a[e] + w1 * b[e] + w2 * c[e];
                *(u32x4*)(MIXED + (size_t)row * D + 1024 + ch * 8) = pack8(o); } }
        }
    }
    SEAM(4);
    if (IN(5)) { CArgs* pa = phase_args();
        skinny_gemm<4>(lds, MIXED + (size_t)T * D, D, WT_OUT, D, D, D / 16, 1, bx, G, wave, lane, tid, SkResN{x_sample, XRES + (size_t)T * D, H + (size_t)T * D, SSQ1 + T});
        pg8::Gemm g{MIXED, WT_OUT, D, D, D, 0}; pg8::StaticOrder S; S.init(T, D, G, bx); pg8::EpiResN E{x_prompt, XRES, H, PSSQ1, (LAS float*)(lds + 131072)}; pg8::gemm_phase(lds, g, S, E); }
    SEAM(5);
    if (IN(7)) { CArgs* pa = phase_args();
        {
            constexpr int I_G = 32 * 88, I_DN = 88 * 32;
            const int nidle = G > 128 ? G - 128 : G, myi = G > 128 ? bx - 128 : bx;
            if (myi >= 0) { LAS float* scr = (LAS float*)(lds + wave * 17408);
                for (int it = myi * 8 + wave; it < 2 * I_G + I_DN; it += nidle * 8) { int r = it;
                    if (r < I_G) { transpose_mat(w_gate, D, FF, WT_GU, 1, 0, nullptr, norm_ffn, r, scr, lane); continue; } r -= I_G;
                    if (r < I_G) { transpose_mat(w_up, D, FF, WT_GU, 2, 0, nullptr, norm_ffn, r, scr, lane); continue; } r -= I_G;
                    transpose_mat(w_down, FF, D, WT_DN, 0, 0, nullptr, nullptr, r, scr, lane); }
                for (int idx = myi * 512 + tid; idx < 2 * 524288; idx += nidle * 512) {
                    const int which = idx >= 524288, i8 = which ? idx - 524288 : idx; const float* src = (which ? cache_mem_v : cache_mem_k) + (size_t)i8 * 8;
                    const f32x4 a = *(const f32x4*)src, b = *(const f32x4*)(src + 4); float f[8] = {a.x, a.y, a.z, a.w, b.x, b.y, b.z, b.w};
                    *(u32x4*)((which ? CMV : CMK) + (size_t)i8 * 8) = pack8(f); }
                __syncthreads(); } }
        skinny_gemm<2>(lds, H + (size_t)T * D, D, WT_MQ, D, D, MEMW / 16, 1, bx, G, wave, lane, tid, SkBf16{QM + (size_t)T * MEMW, MEMW});
        pg8::Gemm g{H, WT_MQ, D, D, D, 0}; pg8::StaticOrder S; S.init(T, MEMW, G, bx); pg8::EpiBf16 E{QM, MEMW}; pg8::gemm_phase(lds, g, S, E); }
    SEAM(7);
    if (IN(8)) { CArgs* pa = phase_args();
        LAS unsigned char* kl = lds; LAS unsigned char* vl2 = lds + 256 * VP;
        for (int grp0 = bx; grp0 < 256; grp0 += G) { const int grp = (G == 256) ? (grp0 & 7) * 32 + (grp0 >> 3) : grp0; const int h = grp >> 6;
#pragma unroll
            for (int j = 0; j < 8; ++j) { const int id = tid + 512 * j, key = id >> 4, chk = id & 15;
                *(LAS bf16x8*)(kl + key * VP + chk * 16) = *(const bf16x8*)(MK + (size_t)key * MEMW + h * 128 + chk * 8);
                *(LAS bf16x8*)(vl2 + key * VP + chk * 16) = *(const bf16x8*)(MV + (size_t)key * MEMW + h * 128 + chk * 8); }
            __syncthreads();
            const int ib = (grp * 8 + wave) & 511;
            mem_att_unit_lds(kl, vl2, QM + (size_t)(ib * 32) * MEMW + h * 128, mem_q_norm, PSSQ1 + (size_t)ib * 32 * 8, 8, 32, SCALE_LOG2, OM + (size_t)(ib * 32) * MEMW + h * 128, lane);
            __syncthreads();
        }
        for (int s1 = bx; s1 < 128; s1 += G) { const int b = s1 >> 2, h = s1 & 3;
            const bf16_t* ck = CMK + (size_t)b * 256 * 512 + h * 128; const bf16_t* cv = CMV + (size_t)b * 256 * 512 + h * 128;
#pragma unroll
            for (int j = 0; j < 8; ++j) { const int id = tid + 512 * j, key = id >> 4, chk = id & 15;
                *(LAS bf16x8*)(kl + key * VP + chk * 16) = *(const bf16x8*)(ck + (size_t)key * MEMW + chk * 8);
                *(LAS bf16x8*)(vl2 + key * VP + chk * 16) = *(const bf16x8*)(cv + (size_t)key * MEMW + chk * 8); }
            __syncthreads();
            if (wave == 0) mem_att_unit_lds(kl, vl2, QM + (size_t)(T + b * 4) * MEMW + h * 128, mem_q_norm, SSQ1 + T + b * 4, 1, 4, SCALE_LOG2, OM + (size_t)(T + b * 4) * MEMW + h * 128, lane);
            __syncthreads();
        }
    }
    SEAM(8);
    if (IN(9)) { CArgs* pa = phase_args();
        skinny_gemm<4>(lds, OM + (size_t)T * MEMW, MEMW, WT_MO, MEMW, MEMW, D / 16, 1, bx, G, wave, lane, tid, SkResN{XRES + (size_t)T * D, XRES + (size_t)T * D, H + (size_t)T * D, SSQ2 + T});
        pg8::Gemm g{OM, WT_MO, MEMW, MEMW, MEMW, 0}; pg8::StaticOrder S; S.init(T, D, G, bx); pg8::EpiResN E{XRES, XRES, H, PSSQ2, (LAS float*)(lds + 131072)}; pg8::gemm_phase(lds, g, S, E); }
    SEAM(9);
    if (IN(11)) { CArgs* pa = phase_args();
        skinny_gemm_nt<3>(lds, H + (size_t)T * D, D, WT_GU, D, D, 2 * FF / 16, 1, bx, G, wave, lane, tid, SkGU{GB + (size_t)T * FF, UPB + (size_t)T * FF, SSQ2 + T});
        pg8::Gemm g{H, WT_GU, D, D, D, 0}; pg8::StaticOrder S; S.init(T, 2 * FF, G, bx); pg8::EpiGUConv E{UPB, PSSQ2, conv_w, conv_b, FIRSTG, FIRSTUP, LASTG, (LAS float*)(lds + 131072 + 4096)}; pg8::gemm_phase(lds, g, S, E); }
    SEAM(11);
    if (IN(12)) { CArgs* pa = phase_args();
        constexpr int NCH = FF / 8;
        for (int idx = gt; idx < 64 * 2 * NCH; idx += NGT) {
            const int ch = idx % NCH, c0 = ch * 8, j = (idx / NCH) & 1, pm = idx / (2 * NCH), row = pm * 256 + j;
            float a[8];
            const float* fg = FIRSTG + ((size_t)pm * 2 + j) * FF + c0; const float* fu = FIRSTUP + ((size_t)pm * 2 + j) * FF + c0;
            const float* p1 = j == 0 ? LASTG + ((size_t)(pm - 1) * 2 + 1) * FF + c0 : FIRSTG + ((size_t)pm * 2 + 0) * FF + c0;
            const float* p2 = j == 0 ? LASTG + ((size_t)(pm - 1) * 2 + 0) * FF + c0 : LASTG + ((size_t)(pm - 1) * 2 + 1) * FF + c0;
            const bool h1 = (j == 1) || pm > 0, h2 = pm > 0;
#pragma unroll
            for (int q = 0; q < 2; ++q) { const f32x4 gc = *(const f32x4*)(fg + 4 * q), uu = *(const f32x4*)(fu + 4 * q);
                const f32x4 z = (f32x4){0.f, 0.f, 0.f, 0.f}; f32x4 g1 = z, g2 = z; if (h1) g1 = *(const f32x4*)(p1 + 4 * q); if (h2) g2 = *(const f32x4*)(p2 + 4 * q);
                const f32x4 w0 = *(const f32x4*)(conv_w + c0 + 4 * q), w1 = *(const f32x4*)(conv_w + FF + c0 + 4 * q), w2 = *(const f32x4*)(conv_w + 2 * FF + c0 + 4 * q), bb = *(const f32x4*)(conv_b + c0 + 4 * q);
#pragma unroll
                for (int e = 0; e < 4; ++e) { const float c = bb[e] + w0[e] * g2[e] + w1[e] * g1[e] + w2[e] * gc[e]; a[4 * q + e] = c / (1.f + __expf(-c)) * uu[e]; } }
            *(u32x4*)(UPB + (size_t)row * FF + c0) = pack8(a);
        }
        for (int idx = gt; idx < 32 * NCH; idx += NGT) {
            const int b = idx / NCH, ch = idx % NCH, c0 = ch * 8;
            float cw0[8], cw1[8], cw2[8], cbv[8], g2[8], g1[8];
            const float* sp = state_conv + ((size_t)b * 2) * FF + c0;
#pragma unroll
            for (int e = 0; e < 8; ++e) { cw0[e] = conv_w[c0 + e]; cw1[e] = conv_w[FF + c0 + e]; cw2[e] = conv_w[2 * FF + c0 + e]; cbv[e] = conv_b[c0 + e]; g2[e] = sp[e]; g1[e] = sp[FF + e]; }
            for (int i = 0; i < 4; ++i) { const int row = T + b * 4 + i; float gc[8], uu[8], a[8];
                unpack8(*(const u32x4*)(GB + (size_t)row * FF + c0), gc); unpack8(*(const u32x4*)(UPB + (size_t)row * FF + c0), uu);
#pragma unroll
                for (int e = 0; e < 8; ++e) { const float c = cbv[e] + cw0[e] * g2[e] + cw1[e] * g1[e] + cw2[e] * gc[e]; a[e] = c / (1.f + __expf(-c)) * uu[e]; g2[e] = g1[e]; g1[e] = gc[e]; }
                *(u32x4*)(UPB + (size_t)row * FF + c0) = pack8(a); }
        }
        for (int idx = gt; idx < 2 * FF + 32 * 2 * FF; idx += NGT) {
            if (idx < 2 * FF) { const int j = idx / FF, f = idx % FF; out[O_PSC + idx] = LASTG[((size_t)63 * 2 + j) * FF + f]; }
            else { const int q = idx - 2 * FF, b = q / (2 * FF), j = (q / FF) & 1, f = q % FF; out[O_SSC + q] = bf2f(GB[(size_t)(T + b * 4 + 2 + j) * FF + f]); }
        }
    }
    SEAM(12);
    if (IN(13)) { CArgs* pa = phase_args();
        skinny_gemm<4>(lds, UPB + (size_t)T * FF, FF, WT_DN, FF, FF, D / 16, 1, bx, G, wave, lane, tid, SkRes{XRES + (size_t)T * D, out + (size_t)T * D});
        pg8::Gemm g{UPB, WT_DN, FF, FF, FF, 0}; pg8::StaticOrder S; S.init(T, D, G, bx); pg8::EpiRes E{XRES, XRES, MP, out, T}; pg8::gemm_phase(lds, g, S, E); }
#undef IN
#undef SEAM
}

#undef out
#undef H
#undef WSP
extern "C" void kernel_launch(void* const* d_in, const int* in_sizes, int n_in, void* d_out, int out_size, void* d_ws, size_t ws_size, hipStream_t stream) {
    static int grid = 0;
    if (grid == 0) {
        if (n_in != 30 || (size_t)out_size != O_END || ws_size < WS_END4) { fprintf(stderr, "kernel_launch: unexpected shapes: n_in %d out %d ws %zu (need %zu)\n", n_in, out_size, ws_size, (size_t)WS_END); grid = -1; return; }
        int dev = 0, cus = 0, per_cu = 0;
        if (hipGetDevice(&dev) != hipSuccess || hipDeviceGetAttribute(&cus, hipDeviceAttributeMultiprocessorCount, dev) != hipSuccess) { grid = -1; return; }
        if (hipFuncSetAttribute((const void*)mega_fwd, hipFuncAttributeMaxDynamicSharedMemorySize, LDS_BYTES) != hipSuccess) { fprintf(stderr, "kernel_launch: hipFuncSetAttribute failed\n"); grid = -1; return; }
        if (hipOccupancyMaxActiveBlocksPerMultiprocessor(&per_cu, (const void*)mega_fwd, 512, LDS_BYTES) != hipSuccess || per_cu < 1) { fprintf(stderr, "kernel_launch: occupancy query gives %d\n", per_cu); per_cu = 1; }
        (void)hipGetLastError();
        grid = cus * 1;
    }
    if (grid < 0) return;
    if (hipMemsetAsync((char*)d_ws + WS_BAR, 0, WS_BAR_BYTES, stream) != hipSuccess) { fprintf(stderr, "kernel_launch: memset of the barrier words failed\n"); return; }
    Args a{};
    for (int i = 0; i < 30; ++i) a.in[i] = (const float*)d_in[i];
    a.out = (float*)d_out; a.ws = (unsigned char*)d_ws;
#if MK_COOP
    a.ph_lo = 0; a.ph_hi = NPH; a.coop = 1;
    void* kargs[] = {&a};
    hipError_t e = hipLaunchCooperativeKernel((const void*)mega_fwd, dim3(grid), dim3(512), kargs, LDS_BYTES, stream);
    if (e != hipSuccess) fprintf(stderr, "kernel_launch: cooperative launch failed: %s (grid %d)\n", hipGetErrorString(e), grid);
#else
    for (int ph = 0; ph < NPH; ++ph) {
        a.ph_lo = ph; a.ph_hi = ph + 1; a.coop = 0;
        hipLaunchKernelGGL(mega_fwd, dim3(grid), dim3(512), LDS_BYTES, stream, a);
    }
#endif
}
```
